# Optimizing an MI355X kernel written in HIP

```python
import jax, jax.numpy as jnp
from jax import lax
import numpy as np

D_MODEL = 2048
BATCH = 8
SEQ = 4096
DEPTH = 2

EXPAND = 2
D_INNER = EXPAND * D_MODEL
N_MIXERS = 2
N_GLA = (DEPTH + 1) // 2
N_RET = DEPTH // 2
EPS = 1e-6
GLA_HEADS = 4
GLA_DK = D_MODEL // 2
GLA_HEAD_K = GLA_DK // GLA_HEADS
GLA_HEAD_V = D_INNER // GLA_HEADS
GLA_GATE_RANK = 16
GLA_GATE_TEMP = 16.0
GLA_CHUNK = 64
RET_HEADS = 8
RET_DK = D_MODEL
RET_HEAD_K = RET_DK // RET_HEADS
RET_HEAD_V = D_INNER // RET_HEADS
RET_CHUNK = 64
ROPE_BASE = 10000.0

kernel_name = "hybrid_gla_retnet_trunk"


def rms_norm(x, g):
    xf = x.astype(jnp.float32)
    xn = xf * lax.rsqrt(jnp.mean(xf * xf, axis=-1, keepdims=True) + EPS)
    return xn.astype(x.dtype) * g


def to_chunks(t, c):
    b, s, h, d = t.shape
    return t.reshape(b, s // c, c, h, d).transpose(1, 0, 3, 2, 4)


def from_chunks(t):
    nc, b, h, c, d = t.shape
    return t.transpose(1, 0, 3, 2, 4).reshape(b, nc * c, h, d)


def gla_mixer(h, w_in, w_a1, w_a2, b_a, head_g, w_out):
    B, S, _ = h.shape
    proj = h @ w_in
    q, k, v, gate = jnp.split(proj, [GLA_DK, 2 * GLA_DK, 2 * GLA_DK + D_INNER], axis=-1)
    log_a = jax.nn.log_sigmoid(((h @ w_a1) @ w_a2 + b_a).astype(jnp.float32)) / GLA_GATE_TEMP
    hd = lambda t, d: t.reshape(B, S, GLA_HEADS, d).astype(jnp.float32)
    qc = to_chunks(hd(q, GLA_HEAD_K) * (GLA_HEAD_K ** -0.5), GLA_CHUNK)
    kc = to_chunks(hd(k, GLA_HEAD_K), GLA_CHUNK)
    vc = to_chunks(hd(v, GLA_HEAD_V), GLA_CHUNK)
    ac = to_chunks(hd(log_a, GLA_HEAD_K), GLA_CHUNK)
    causal = jnp.tril(jnp.ones((GLA_CHUNK, GLA_CHUNK), dtype=bool))[:, :, None]

    def step(state, inp):
        qb, kb, vb, ab = inp
        cum = jnp.cumsum(ab, axis=-2)
        last = cum[..., -1:, :]
        inter = jnp.einsum('bhtk,bhkv->bhtv', qb * jnp.exp(cum), state)
        diff = cum[:, :, :, None, :] - cum[:, :, None, :, :]
        decay = jnp.where(causal, jnp.exp(jnp.where(causal, diff, 0.0)), 0.0)
        scores = jnp.einsum('bhtk,bhsk,bhtsk->bhts', qb, kb, decay)
        intra = jnp.einsum('bhts,bhsv->bhtv', scores, vb)
        new_state = jnp.exp(last)[:, :, 0, :, None] * state + jnp.einsum(
            'bhsk,bhsv->bhkv', kb * jnp.exp(last - cum), vb)
        return new_state, inter + intra

    s0 = jnp.zeros((B, GLA_HEADS, GLA_HEAD_K, GLA_HEAD_V), jnp.float32)
    _, o = lax.scan(step, s0, (qc, kc, vc, ac))
    o = from_chunks(o)
    o = o * lax.rsqrt(jnp.mean(o * o, axis=-1, keepdims=True) + EPS)
    o = o.reshape(B, S, D_INNER).astype(h.dtype) * head_g
    return (o * jax.nn.silu(gate)) @ w_out


def apply_rotary(t, cos, sin):
    t1, t2 = jnp.split(t, 2, axis=-1)
    return jnp.concatenate([t1 * cos - t2 * sin, t2 * cos + t1 * sin], axis=-1)


def retention_mixer(h, positions, w_in, gn_g, gn_b, w_out):
    B, S, _ = h.shape
    proj = h @ w_in
    q, k, v, gate = jnp.split(proj, [RET_DK, 2 * RET_DK, 2 * RET_DK + D_INNER], axis=-1)
    q = q.reshape(B, S, RET_HEADS, RET_HEAD_K).astype(jnp.float32)
    k = k.reshape(B, S, RET_HEADS, RET_HEAD_K).astype(jnp.float32) * (RET_HEAD_K ** -0.5)
    v = v.reshape(B, S, RET_HEADS, RET_HEAD_V).astype(jnp.float32)
    inv_freq = ROPE_BASE ** (-jnp.arange(RET_HEAD_K // 2, dtype=jnp.float32) / (RET_HEAD_K // 2))
    ang = positions.astype(jnp.float32)[..., None] * inv_freq
    cos, sin = jnp.cos(ang)[:, :, None, :], jnp.sin(ang)[:, :, None, :]
    q, k = apply_rotary(q, cos, sin), apply_rotary(k, cos, sin)

    log_gamma = jnp.log1p(-jnp.exp2(-5.0 - jnp.arange(RET_HEADS, dtype=jnp.float32)))
    idx = jnp.arange(RET_CHUNK, dtype=jnp.float32)
    dpos = idx[:, None] - idx[None, :]
    dmat = jnp.where(dpos >= 0, jnp.exp(log_gamma[:, None, None] * jnp.where(dpos >= 0, dpos, 0.0)), 0.0)
    xi = jnp.exp(log_gamma[:, None] * (idx + 1.0))[..., None]
    zeta = jnp.exp(log_gamma[:, None] * (RET_CHUNK - 1.0 - idx))[..., None]
    g_chunk = jnp.exp(log_gamma * RET_CHUNK)[:, None, None]

    def step(state, inp):
        qb, kb, vb = inp
        scores = jnp.einsum('bhtk,bhsk->bhts', qb, kb) * dmat
        intra = jnp.einsum('bhts,bhsv->bhtv', scores, vb)
        inter = jnp.einsum('bhtk,bhkv->bhtv', qb, state) * xi
        new_state = g_chunk * state + jnp.einsum('bhsk,bhsv->bhkv', kb * zeta, vb)
        return new_state, intra + inter

    s0 = jnp.zeros((B, RET_HEADS, RET_HEAD_K, RET_HEAD_V), jnp.float32)
    _, o = lax.scan(step, s0, (to_chunks(q, RET_CHUNK), to_chunks(k, RET_CHUNK), to_chunks(v, RET_CHUNK)))
    o = from_chunks(o)
    mu = jnp.mean(o, axis=-1, keepdims=True)
    var = jnp.mean(jnp.square(o - mu), axis=-1, keepdims=True)
    o = ((o - mu) * lax.rsqrt(var + EPS)).reshape(B, S, D_INNER).astype(h.dtype)
    o = o * gn_g + gn_b
    return (o * jax.nn.silu(gate)) @ w_out


def setup_inputs(seed: int = 0) -> dict:
    key = jax.random.key(seed)
    ks = jax.random.split(key, 16)
    nrm = lambda k, shape, fan_in: jax.random.normal(k, shape, jnp.float32) * fan_in ** -0.5
    x = jax.random.normal(ks[0], (BATCH, SEQ, D_MODEL), jnp.float32)
    offsets = jax.random.randint(ks[1], (BATCH, 1), 0, 1024, dtype=jnp.int32)
    positions = offsets + jnp.arange(SEQ, dtype=jnp.int32)[None, :]
    gla_in = 2 * GLA_DK + 2 * D_INNER
    ret_in = 2 * RET_DK + 2 * D_INNER
    return {
        "x": x,
        "positions": positions,
        "gla_norm": 1.0 + 0.02 * jax.random.normal(ks[2], (N_GLA, D_MODEL), jnp.float32),
        "gla_w_in": nrm(ks[3], (N_GLA, D_MODEL, gla_in), D_MODEL),
        "gla_w_a1": nrm(ks[4], (N_GLA, D_MODEL, GLA_GATE_RANK), D_MODEL),
        "gla_w_a2": nrm(ks[5], (N_GLA, GLA_GATE_RANK, GLA_DK), GLA_GATE_RANK),
        "gla_b_a": 0.1 * jax.random.normal(ks[6], (N_GLA, GLA_DK), jnp.float32),
        "gla_head_g": 1.0 + 0.02 * jax.random.normal(ks[7], (N_GLA, D_INNER), jnp.float32),
        "gla_w_out": nrm(ks[8], (N_GLA, D_INNER, D_MODEL), D_INNER),
        "ret_norm": 1.0 + 0.02 * jax.random.normal(ks[9], (N_RET, D_MODEL), jnp.float32),
        "ret_w_in": nrm(ks[10], (N_RET, D_MODEL, ret_in), D_MODEL),
        "ret_gn_g": 1.0 + 0.02 * jax.random.normal(ks[11], (N_RET, D_INNER), jnp.float32),
        "ret_gn_b": 0.02 * jax.random.normal(ks[12], (N_RET, D_INNER), jnp.float32),
        "ret_w_out": nrm(ks[13], (N_RET, D_INNER, D_MODEL), D_INNER),
        "final_norm": 1.0 + 0.02 * jax.random.normal(ks[14], (D_MODEL,), jnp.float32),
    }


def reference(x, positions, gla_norm, gla_w_in, gla_w_a1, gla_w_a2, gla_b_a, gla_head_g, gla_w_out,
              ret_norm, ret_w_in, ret_gn_g, ret_gn_b, ret_w_out, final_norm):
    h = x
    for i in range(DEPTH):
        j = i // N_MIXERS
        if i % N_MIXERS == 0:
            h = h + gla_mixer(rms_norm(h, gla_norm[j]), gla_w_in[j], gla_w_a1[j], gla_w_a2[j],
                              gla_b_a[j], gla_head_g[j], gla_w_out[j])
        else:
            h = h + retention_mixer(rms_norm(h, ret_norm[j]), positions, ret_w_in[j],
                                    ret_gn_g[j], ret_gn_b[j], ret_w_out[j])
    return rms_norm(h, final_norm)
```

```cpp
#include <hip/hip_runtime.h>
#include <hip/hip_cooperative_groups.h>
#include <cstdio>
#include <cstdint>
namespace cg = cooperative_groups;

#define LAS __attribute__((address_space(3)))
typedef unsigned short bf16_t;
typedef short bf16x8 __attribute__((ext_vector_type(8)));
typedef short s16x4 __attribute__((ext_vector_type(4)));
typedef float f32x4 __attribute__((ext_vector_type(4)));
typedef float f32x2 __attribute__((ext_vector_type(2)));
typedef float f32x16 __attribute__((ext_vector_type(16)));
typedef unsigned u32x4 __attribute__((ext_vector_type(4)));
typedef unsigned u32x2 __attribute__((ext_vector_type(2)));
typedef __bf16 bf2_t __attribute__((ext_vector_type(2)));

constexpr int T = 32768, D = 2048, DI = 4096, SEQ = 4096;
constexpr int N0 = 11264, N1 = 12288;
constexpr float EPS = 1e-6f;
constexpr size_t MiB = 1u << 20;
constexpr size_t WS_W0T = 0, WS_WOUT0T = 44 * MiB, WS_W1T = 64 * MiB, WS_WOUT1T = 112 * MiB, WS_H1BF = 128 * MiB, WS_PROJ = 256 * MiB;
constexpr size_t WS_ROT = 0, WS_SUMSQ1 = 32 * MiB;
constexpr int LDS_BYTES = 143360;

__device__ __forceinline__ unsigned pk2(float lo, float hi) { bf2_t r = __builtin_convertvector((f32x2){lo, hi}, bf2_t); return __builtin_bit_cast(unsigned, r); }
__device__ __forceinline__ float bflo(unsigned u) { return __builtin_bit_cast(float, u << 16); }
__device__ __forceinline__ float bfhi(unsigned u) { return __builtin_bit_cast(float, u & 0xffff0000u); }
__device__ __forceinline__ float wave_sum(float v) {
#pragma unroll
    for (int o = 1; o < 64; o <<= 1) v += __shfl_xor(v, o);
    return v;
}

namespace pg8 {
constexpr int BM = 256, BK = 64, HALF = 128, HTB = HALF * BK * 2, STAGE_BYTES = 8 * HTB, NXCD = 8, WGM = 8;
__host__ __device__ __forceinline__ int lds_byte(int r, int c) { const int st = (r >> 4) * 2 + (c >> 5), rr = r & 15, cc = c & 31, ob = rr * 64 + cc * 2; return st * 1024 + (ob ^ (((ob >> 9) & 1) << 5)); }
__host__ __device__ __forceinline__ void stage_rc(int b, int& R, int& C) { const int st = b / 1024, sb = b % 1024, swz = sb ^ (((sb >> 9) & 1) << 5); R = (st >> 1) * 16 + swz / 64; C = (st & 1) * 32 + (swz % 64) / 2; }
__host__ __device__ __forceinline__ int perm32(int rho) { const int n = rho >> 4, i = rho & 15; return 8 * (i >> 2) + 4 * n + (i & 3); }

struct Unit { int pm, pn; };
struct Gemm { const bf16_t* A; const bf16_t* Bt; int M, N, K, lda; };

struct StaticOrder {
    int nM, nN, nwg, G, c;
    __device__ void init(int M, int N, int G_, int c_) { nM = M / BM; nN = N / BM; nwg = nM * nN; G = G_; c = c_; }
    __device__ bool next(int i, Unit& u) const {
        const long L = (long)i * G + c; if (L >= nwg) return false;
        int wgid = (int)L; { const int q = nwg / NXCD, r = nwg % NXCD, xcd = wgid % NXCD, off = wgid / NXCD; wgid = (xcd < r ? xcd * (q + 1) : r * (q + 1) + (xcd - r) * q) + off; }
        const int nig = WGM * nN, gid = wgid / nig, fm = gid * WGM, gsz = (nM - fm) < WGM ? (nM - fm) : WGM;
        u.pm = fm + ((wgid % nig) % gsz); u.pn = (wgid % nig) / gsz; return true;
    }
};


struct EpiProj {
    static constexpr bool PERM = true;
    bf16_t* O; int ldc; int mode;
    const float* rowsumsq;
    const float* b_a;
    const f32x2* rot;
    __device__ __forceinline__ void operator()(const f32x4 (&acc)[2][2][4][2], const Unit& u, int wr, int wc, int fr, int fq) const {
        const int row0 = u.pm * BM + wr * 64 + fr, col0 = u.pn * BM + wc * 32 + 8 * fq;
        const bool is_a = (mode == 0) && (u.pn >= 40);
        const bool is_rot = (mode == 1) && (u.pn < 16);
        f32x4 bv[2][2];
#pragma unroll
        for (int bj = 0; bj < 2; ++bj)
#pragma unroll
            for (int n = 0; n < 2; ++n) bv[bj][n] = is_a ? *(const f32x4*)(b_a + (col0 - 10240) + bj * HALF + 4 * n) : (f32x4){0.f, 0.f, 0.f, 0.f};
#pragma unroll
        for (int ai = 0; ai < 2; ++ai)
#pragma unroll
            for (int m = 0; m < 4; ++m) {
                const int row = row0 + ai * HALF + m * 16;
                const float rs = rowsumsq ? rsqrtf(rowsumsq[row] * (1.0f / D) + EPS) : 1.0f;
                f32x4 v[2][2];
#pragma unroll
                for (int bj = 0; bj < 2; ++bj)
#pragma unroll
                    for (int n = 0; n < 2; ++n) v[bj][n] = acc[ai][bj][m][n] * rs;
                if (is_a) {
#pragma unroll
                    for (int bj = 0; bj < 2; ++bj)
#pragma unroll
                        for (int n = 0; n < 2; ++n)
#pragma unroll
                            for (int j = 0; j < 4; ++j) { const float x = v[bj][n][j] + bv[bj][n][j]; v[bj][n][j] = (fminf(x, 0.f) - __logf(1.0f + __expf(-fabsf(x)))) * (1.0f / 16.0f); }
                }
                if (is_rot) {
                    const f32x2* rp = rot + (size_t)row * 128 + wc * 32 + 8 * fq;
#pragma unroll
                    for (int n = 0; n < 2; ++n) {
                        const f32x4 t0 = *(const f32x4*)(rp + 4 * n), t1 = *(const f32x4*)(rp + 4 * n + 2);
                        const float cs[4] = {t0[0], t0[2], t1[0], t1[2]}, sn[4] = {t0[1], t0[3], t1[1], t1[3]};
#pragma unroll
                        for (int j = 0; j < 4; ++j) { const float x1 = v[0][n][j], x2 = v[1][n][j]; v[0][n][j] = x1 * cs[j] - x2 * sn[j]; v[1][n][j] = x2 * cs[j] + x1 * sn[j]; }
                    }
                }
                bf16_t* rowp = O + (size_t)row * ldc + col0;
#pragma unroll
                for (int bj = 0; bj < 2; ++bj) {
                    u32x4 w; w.x = pk2(v[bj][0][0], v[bj][0][1]); w.y = pk2(v[bj][0][2], v[bj][0][3]); w.z = pk2(v[bj][1][0], v[bj][1][1]); w.w = pk2(v[bj][1][2], v[bj][1][3]);
                    *(u32x4*)(rowp + bj * HALF) = w;
                }
            }
    }
};
struct EpiOut {
    static constexpr bool PERM = false;
    const float* resid; float* out; bf16_t* outbf; float* sumsq;
    __device__ __forceinline__ void operator()(const f32x4 (&acc)[2][2][4][2], const Unit& u, int wr, int wc, int fr, int fq) const {
        const int row0 = u.pm * BM + wr * 64 + fr, col0 = u.pn * BM + wc * 32 + 4 * fq;
#pragma unroll
        for (int ai = 0; ai < 2; ++ai)
#pragma unroll
            for (int m = 0; m < 4; ++m) {
                const int row = row0 + ai * HALF + m * 16;
                const size_t off = (size_t)row * D + col0;
                float ss = 0.f;
#pragma unroll
                for (int bj = 0; bj < 2; ++bj)
#pragma unroll
                    for (int n = 0; n < 2; ++n) {
                        const f32x4 r = *(const f32x4*)(resid + off + bj * HALF + n * 16);
                        const f32x4 v = acc[ai][bj][m][n] + r;
                        *(f32x4*)(out + off + bj * HALF + n * 16) = v;
                        ss += (v[0] * v[0] + v[1] * v[1]) + (v[2] * v[2] + v[3] * v[3]);
                        if (outbf) { u32x2 w; w.x = pk2(v[0], v[1]); w.y = pk2(v[2], v[3]); *(u32x2*)(outbf + off + bj * HALF + n * 16) = w; }
                    }
                if (sumsq) { ss += __shfl_xor(ss, 16); ss += __shfl_xor(ss, 32); if (fq == 0) atomicAdd(sumsq + row, ss); }
            }
    }
};

template <class Epi>
__device__ __forceinline__ void gemm_phase(LAS unsigned char* lds, const Gemm g, const StaticOrder& S, const Epi& E) {
    const int tid = threadIdx.x, wid = __builtin_amdgcn_readfirstlane(tid >> 6), lane = tid & 63, wr = wid >> 2, wc = wid & 3, fr = lane & 15, fq = lane >> 4;
    const int K = g.K, nt = K / BK, lda = g.lda;
    unsigned voffA[2], voffB[2];
#pragma unroll
    for (int i = 0; i < 2; ++i) { int R, C; stage_rc(tid * 16 + i * 8192, R, C); const int Rb = Epi::PERM ? ((R & ~31) + perm32(R & 31)) : R;
        voffA[i] = (unsigned)(R * lda + C) * 2u; voffB[i] = (unsigned)(Rb * K + C) * 2u; }
    const size_t kstep = (size_t)(BK * 2);
    const size_t hstepA = (size_t)HALF * lda * 2, hstepB = (size_t)HALF * K * 2;
    const size_t tstepA = 2 * hstepA, tstepB = 2 * hstepB;
    const unsigned ldsw = (unsigned)wid * 1024u;
    const int aoff = lds_byte(wr * 64 + fr, fq * 8), boff = lds_byte(wc * 32 + fr, fq * 8);
#define PG8_SA(b, h) (((b) * 2 + (h)) * HTB)
#define PG8_SB(b, h) ((4 + (b) * 2 + (h)) * HTB)
#define PG8_STAGE(bufoff, gbase, voff) do { _Pragma("unroll") for (int _i = 0; _i < 2; ++_i) \
        __builtin_amdgcn_global_load_lds((const unsigned*)((const char*)(gbase) + (voff)[_i]), (LAS unsigned*)(lds + (bufoff) + ldsw + _i * 8192), 16, 0, 0); } while (0)
#define PG8_LDA(dst, b, h) do { _Pragma("unroll") for (int m = 0; m < 4; ++m) _Pragma("unroll") for (int k = 0; k < 2; ++k) dst[m][k] = *(const LAS bf16x8*)(lds + PG8_SA(b, h) + aoff + m * 2048 + k * 1024); } while (0)
#define PG8_LDB(dst, b, h) do { _Pragma("unroll") for (int n = 0; n < 2; ++n) _Pragma("unroll") for (int k = 0; k < 2; ++k) dst[n][k] = *(const LAS bf16x8*)(lds + PG8_SB(b, h) + boff + n * 2048 + k * 1024); } while (0)
#define PG8_MMA(ai, bj, At, Bt) do { __builtin_amdgcn_s_setprio(1); _Pragma("unroll") for (int m = 0; m < 4; ++m) _Pragma("unroll") for (int n = 0; n < 2; ++n) _Pragma("unroll") for (int k = 0; k < 2; ++k) \
        acc[ai][bj][m][n] = __builtin_amdgcn_mfma_f32_16x16x32_bf16(Bt[n][k], At[m][k], acc[ai][bj][m][n], 0, 0, 0); __builtin_amdgcn_s_setprio(0); } while (0)
#define PG8_WAIT_V(n) asm volatile("s_waitcnt vmcnt(" #n ")" ::: "memory")
#define PG8_WAIT_L(n) asm volatile("s_waitcnt lgkmcnt(" #n ")" ::: "memory")
#define PG8_BAR __builtin_amdgcn_s_barrier()
#define PG8_SCHED __builtin_amdgcn_sched_barrier(0)
    Unit cur, nxt; int ui = 0;
    if (!S.next(0, cur)) return;
    f32x4 acc[2][2][4][2];
#pragma unroll
    for (int a = 0; a < 2; ++a)
#pragma unroll
        for (int b = 0; b < 2; ++b)
#pragma unroll
            for (int m = 0; m < 4; ++m)
#pragma unroll
                for (int n = 0; n < 2; ++n) acc[a][b][m][n] = (f32x4){0.f, 0.f, 0.f, 0.f};
    bf16x8 At[4][2], B0[2][2], B1[2][2];
    const char* cA = (const char*)g.A + (size_t)cur.pm * tstepA; const char* cB = (const char*)g.Bt + (size_t)cur.pn * tstepB;
    PG8_STAGE(PG8_SB(0, 0), cB, voffB); PG8_STAGE(PG8_SB(0, 1), cB + hstepB, voffB); PG8_STAGE(PG8_SA(0, 0), cA, voffA); PG8_STAGE(PG8_SA(0, 1), cA + hstepA, voffA);
    if (wr == 1) PG8_BAR;
    PG8_WAIT_V(2); PG8_BAR;
    PG8_STAGE(PG8_SB(1, 0), cB + kstep, voffB); PG8_STAGE(PG8_SA(1, 0), cA + kstep, voffA); PG8_STAGE(PG8_SB(1, 1), cB + hstepB + kstep, voffB);
    PG8_WAIT_V(6); PG8_BAR;
    for (;;) {
        const bool has_next = S.next(ui + 1, nxt);
        const char* nA = has_next ? (const char*)g.A + (size_t)nxt.pm * tstepA : cA; const char* nB = has_next ? (const char*)g.Bt + (size_t)nxt.pn * tstepB : cB;
        for (int t = 0; t < nt; t += 2) {
            const bool last = (t == nt - 2);
            const char* a1 = cA + (size_t)(t + 1) * kstep;
            const char* a2 = last ? nA : cA + (size_t)(t + 2) * kstep; const char* b2 = last ? nB : cB + (size_t)(t + 2) * kstep;
            const char* a3 = a2 + kstep; const char* b3 = b2 + kstep;
            PG8_LDB(B0, 0, 0); PG8_LDB(B1, 0, 1); PG8_SCHED; PG8_LDA(At, 0, 0); PG8_STAGE(PG8_SA(1, 1), a1 + hstepA, voffA);
            PG8_WAIT_V(8); PG8_WAIT_L(0); PG8_BAR; PG8_MMA(0, 0, At, B0); PG8_MMA(0, 1, At, B1); PG8_BAR; PG8_SCHED;
            PG8_LDA(At, 0, 1); PG8_STAGE(PG8_SB(0, 0), b2, voffB); PG8_STAGE(PG8_SB(0, 1), b2 + hstepB, voffB); PG8_STAGE(PG8_SA(0, 0), a2, voffA);
            PG8_WAIT_V(8); PG8_WAIT_L(0); PG8_BAR; PG8_MMA(1, 0, At, B0); PG8_MMA(1, 1, At, B1); PG8_BAR; PG8_SCHED;
            PG8_LDB(B0, 1, 0); PG8_LDB(B1, 1, 1); PG8_SCHED; PG8_LDA(At, 1, 0); PG8_STAGE(PG8_SA(0, 1), a2 + hstepA, voffA);
            PG8_WAIT_V(8); PG8_WAIT_L(0); PG8_BAR; PG8_MMA(0, 0, At, B0); PG8_MMA(0, 1, At, B1); PG8_BAR; PG8_SCHED;
            PG8_LDA(At, 1, 1); PG8_STAGE(PG8_SB(1, 0), b3, voffB); PG8_STAGE(PG8_SB(1, 1), b3 + hstepB, voffB); PG8_STAGE(PG8_SA(1, 0), a3, voffA);
            PG8_WAIT_V(8); PG8_WAIT_L(0); PG8_BAR; PG8_MMA(1, 0, At, B0); PG8_MMA(1, 1, At, B1); PG8_BAR; PG8_SCHED;
        }
        if (wr == 0) PG8_BAR;
        E(acc, cur, wr, wc, fr, fq);
        if (!has_next) break;
#pragma unroll
        for (int a = 0; a < 2; ++a)
#pragma unroll
            for (int b = 0; b < 2; ++b)
#pragma unroll
                for (int m = 0; m < 4; ++m)
#pragma unroll
                    for (int n = 0; n < 2; ++n) acc[a][b][m][n] = (f32x4){0.f, 0.f, 0.f, 0.f};
        cur = nxt; cA = nA; cB = nB; ++ui;
        if (wr == 1) PG8_BAR;
    }
    PG8_WAIT_V(0);
    PG8_BAR;
#undef PG8_SA
#undef PG8_SB
#undef PG8_STAGE
#undef PG8_LDA
#undef PG8_LDB
#undef PG8_MMA
#undef PG8_WAIT_V
#undef PG8_WAIT_L
#undef PG8_BAR
#undef PG8_SCHED
}
}

constexpr int QT_OFF = 0, KH_OFF = 33792, KT_OFF = 67584, VT_OFF = 104448, PB_OFF = 122880, EV_OFF = 132096, TOT_OFF = 133120;
constexpr int QSTR = 264, TSTR = 72;
#define MFMA32(a, b, c) __builtin_amdgcn_mfma_f32_32x32x16_bf16((a), (b), (c), 0, 0, 0)
__device__ __forceinline__ int crow(int i, int h) { return (i & 3) + 8 * (i >> 2) + 4 * h; }

template <int MODE>
__device__ __forceinline__ void scan_phase(LAS unsigned char* lds, bf16_t* proj, int vcu, int G) {
    constexpr int H = MODE ? 8 : 4, DV = MODE ? 512 : 1024, NSL = DV / 128, LD = MODE ? N1 : N0;
    constexpr int KOFF = MODE ? 2048 : 1024, VOFF = MODE ? 4096 : 2048, AOFF = 10240;
    const int tid = threadIdx.x, lane = tid & 63, w = __builtin_amdgcn_readfirstlane(tid >> 6);
    const int r = lane & 31, h2 = lane >> 5, vb = w & 3, kh = w >> 2;
    const int cp = tid & 127, sq = w >> 1;
    const int vp = lane, s8 = w;
    LAS float* EV = (LAS float*)(lds + EV_OFF);
    LAS float* TOT = (LAS float*)(lds + TOT_OFF);
    LAS float* XCH = (LAS float*)(lds + QT_OFF);
    for (int item = vcu; item < 256; item += G) {
        const int vs = item % NSL, hh = (item / NSL) % H, b = item / (NSL * H);
        const size_t rowb = (size_t)b * SEQ;
        const bf16_t* qbase = proj + rowb * LD + hh * 256;
        bf16_t* vbase = proj + rowb * LD + VOFF + hh * DV + vs * 128;
        const float lg = MODE ? log1pf(-exp2f(-5.0f - (float)hh)) : 0.f;
        const unsigned qlo = ((unsigned)(16 * sq) * LD + 2 * cp) * 2u, vlo = ((unsigned)(8 * s8) * LD + 2 * vp) * 2u;
        f32x16 S[4];
#pragma unroll
        for (int j = 0; j < 4; ++j)
#pragma unroll
            for (int i = 0; i < 16; ++i) S[j][i] = 0.f;
        unsigned rq[16], rk[16], ra[16], rv[8];
#define SCAN_LOAD(c) do { const char* _p = (const char*)(qbase + (size_t)((c) * 64) * LD); \
            _Pragma("unroll") for (int i = 0; i < 16; ++i) { const char* _pi = _p + (size_t)i * (LD * 2); \
                rq[i] = *(const unsigned*)(_pi + qlo); rk[i] = *(const unsigned*)(_pi + KOFF * 2 + qlo); \
                if (MODE == 0) ra[i] = *(const unsigned*)(_pi + AOFF * 2 + qlo); } \
            const char* _v = (const char*)(vbase + (size_t)((c) * 64) * LD); \
            _Pragma("unroll") for (int i = 0; i < 8; ++i) rv[i] = *(const unsigned*)(_v + (size_t)i * (LD * 2) + vlo); } while (0)
        SCAN_LOAD(0);
        for (int c = 0; c < 64; ++c) {
            float run0 = 0.f, run1 = 0.f;
            if (MODE == 0) {
                float a0 = 0.f, a1 = 0.f;
#pragma unroll
                for (int i = 0; i < 16; ++i) { a0 += bflo(ra[i]); a1 += bfhi(ra[i]); }
                *(LAS f32x2*)(TOT + sq * 256 + 2 * cp) = (f32x2){a0, a1};
            }
            __syncthreads();
            float lgc = lg;
            if (MODE == 0) {
#pragma unroll
                for (int q = 0; q < 3; ++q) if (q < sq) { const f32x2 t = *(LAS f32x2*)(TOT + q * 256 + 2 * cp); run0 += t[0]; run1 += t[1]; }
            } else {
                asm volatile("" : "+v"(lgc));
            }
#pragma unroll
            for (int hf = 0; hf < 2; ++hf) {
                unsigned kt0[4], kt1[4];
#pragma unroll
                for (int ii = 0; ii < 8; ii += 2) {
                    float ka[2], kb2[2];
#pragma unroll
                    for (int d = 0; d < 2; ++d) {
                        const int i = 8 * hf + ii + d, s = 16 * sq + i;
                        float cu0, cu1;
                        if (MODE == 0) { run0 += bflo(ra[i]); run1 += bfhi(ra[i]); cu0 = run0; cu1 = run1; }
                        else { cu0 = lgc * (float)(s + 1); cu1 = cu0; }
                        const float e0 = __expf(cu0), e1 = __expf(cu1), f0 = __expf(-cu0), f1 = __expf(-cu1);
                        *(LAS unsigned*)(lds + QT_OFF + (s * QSTR + 2 * cp) * 2) = pk2(bflo(rq[i]) * e0, bfhi(rq[i]) * e1);
                        ka[d] = bflo(rk[i]) * f0; kb2[d] = bfhi(rk[i]) * f1;
                        *(LAS unsigned*)(lds + KH_OFF + (s * QSTR + 2 * cp) * 2) = pk2(ka[d], kb2[d]);
                        if (i == 15 && sq == 3) *(LAS f32x2*)(EV + 2 * cp) = (f32x2){e0, e1};
                    }
                    kt0[ii >> 1] = pk2(ka[0], ka[1]); kt1[ii >> 1] = pk2(kb2[0], kb2[1]);
                }
                LAS unsigned char* kt = lds + KT_OFF + ((2 * cp) * TSTR + 16 * sq + 8 * hf) * 2;
                *(LAS u32x4*)(kt) = (u32x4){kt0[0], kt0[1], kt0[2], kt0[3]};
                *(LAS u32x4*)(kt + TSTR * 2) = (u32x4){kt1[0], kt1[1], kt1[2], kt1[3]};
            }
            {
                u32x4 v0, v1;
                v0.x = (rv[0] & 0xffffu) | (rv[1] << 16); v0.y = (rv[2] & 0xffffu) | (rv[3] << 16); v0.z = (rv[4] & 0xffffu) | (rv[5] << 16); v0.w = (rv[6] & 0xffffu) | (rv[7] << 16);
                v1.x = (rv[0] >> 16) | (rv[1] & 0xffff0000u); v1.y = (rv[2] >> 16) | (rv[3] & 0xffff0000u); v1.z = (rv[4] >> 16) | (rv[5] & 0xffff0000u); v1.w = (rv[6] >> 16) | (rv[7] & 0xffff0000u);
                LAS unsigned char* vt = lds + VT_OFF + ((2 * vp) * TSTR + 8 * s8) * 2;
                *(LAS u32x4*)(vt) = v0; *(LAS u32x4*)(vt + TSTR * 2) = v1;
            }
            __syncthreads();
            if (c + 1 < 64) SCAN_LOAD(c + 1);
            if (w < 3) {
                const int tb = (w >= 1) ? 1 : 0, sb = (w == 2) ? 1 : 0;
                f32x16 P;
#pragma unroll
                for (int i = 0; i < 16; ++i) P[i] = 0.f;
                const LAS unsigned char* qa = lds + QT_OFF + ((32 * tb + r) * QSTR + 8 * h2) * 2;
                const LAS unsigned char* kb_ = lds + KH_OFF + ((32 * sb + r) * QSTR + 8 * h2) * 2;
#pragma unroll
                for (int st = 0; st < 16; ++st) P = MFMA32(*(const LAS bf16x8*)(qa + st * 32), *(const LAS bf16x8*)(kb_ + st * 32), P);
                LAS bf16_t* pb = (LAS bf16_t*)(lds + PB_OFF);
#pragma unroll
                for (int i = 0; i < 16; ++i) {
                    const int tr = crow(i, h2);
                    const float pv = (tb == sb && r > tr) ? 0.f : P[i];
                    pb[(32 * tb + tr) * TSTR + 32 * sb + r] = (bf16_t)(pk2(pv, 0.f) & 0xffffu);
                }
            }
            f32x16 op0, op1;
#pragma unroll
            for (int i = 0; i < 16; ++i) { op0[i] = 0.f; op1[i] = 0.f; }
#pragma unroll
            for (int j = 0; j < 4; ++j) {
                const int kb = 4 * kh + j;
#pragma unroll
                for (int st = 0; st < 2; ++st) {
                    u32x4 sp; sp.x = pk2(S[j][8 * st + 0], S[j][8 * st + 1]); sp.y = pk2(S[j][8 * st + 2], S[j][8 * st + 3]); sp.z = pk2(S[j][8 * st + 4], S[j][8 * st + 5]); sp.w = pk2(S[j][8 * st + 6], S[j][8 * st + 7]);
                    const bf16x8 sfrag = __builtin_bit_cast(bf16x8, sp);
                    const LAS unsigned char* q0 = lds + QT_OFF + (r * QSTR + 32 * kb + 16 * st + 4 * h2) * 2;
                    const s16x4 lo0 = *(const LAS s16x4*)(q0), hi0 = *(const LAS s16x4*)(q0 + 16);
                    const s16x4 lo1 = *(const LAS s16x4*)(q0 + 32 * QSTR * 2), hi1 = *(const LAS s16x4*)(q0 + 32 * QSTR * 2 + 16);
                    op0 = MFMA32(__builtin_shufflevector(lo0, hi0, 0, 1, 2, 3, 4, 5, 6, 7), sfrag, op0);
                    op1 = MFMA32(__builtin_shufflevector(lo1, hi1, 0, 1, 2, 3, 4, 5, 6, 7), sfrag, op1);
                }
            }
            __syncthreads();
            f32x16 o;
            {
#pragma unroll
                for (int i = 0; i < 16; ++i) { XCH[w * 1024 + i * 64 + lane] = kh ? op0[i] : op1[i]; o[i] = kh ? op1[i] : op0[i]; }
            }
            bf16x8 vf[4];
#pragma unroll
            for (int st = 0; st < 4; ++st) vf[st] = *(const LAS bf16x8*)(lds + VT_OFF + ((32 * vb + r) * TSTR + 16 * st + 8 * h2) * 2);
            {
                const LAS unsigned char* pa = lds + PB_OFF + ((32 * kh + r) * TSTR + 8 * h2) * 2;
                o = MFMA32(*(const LAS bf16x8*)(pa), vf[0], o);
                o = MFMA32(*(const LAS bf16x8*)(pa + 32), vf[1], o);
                if (kh) { o = MFMA32(*(const LAS bf16x8*)(pa + 64), vf[2], o); o = MFMA32(*(const LAS bf16x8*)(pa + 96), vf[3], o); }
            }
#pragma unroll
            for (int j = 0; j < 4; ++j) {
                const int kb = 4 * kh + j;
                const LAS unsigned char* ka = lds + KT_OFF + ((32 * kb + r) * TSTR + 8 * h2) * 2;
#pragma unroll
                for (int st = 0; st < 4; ++st) S[j] = MFMA32(*(const LAS bf16x8*)(ka + st * 32), vf[st], S[j]);
#pragma unroll
                for (int g4 = 0; g4 < 4; ++g4) { const f32x4 e = *(const LAS f32x4*)(EV + 32 * kb + 8 * g4 + 4 * h2);
#pragma unroll
                    for (int q = 0; q < 4; ++q) S[j][4 * g4 + q] *= e[q]; }
            }
            __syncthreads();
#pragma unroll
            for (int i = 0; i < 16; ++i) o[i] += XCH[(w ^ 4) * 1024 + i * 64 + lane];
            {
                char* op = (char*)(vbase + (size_t)(c * 64 + 32 * kh) * LD);
                const unsigned olo = ((unsigned)(4 * h2) * LD + 32 * vb + r) * 2u;
#pragma unroll
                for (int i = 0; i < 16; ++i) *(bf16_t*)(op + (size_t)((i & 3) + 8 * (i >> 2)) * (LD * 2) + olo) = (bf16_t)(pk2(o[i], 0.f) & 0xffffu);
            }
        }
#undef SCAN_LOAD
        __syncthreads();
    }
}

template <int MODE>
__device__ __forceinline__ void ew_phase(bf16_t* proj, const float* gain, const float* bias, int gw, int NGW, int lane) {
    constexpr int H = MODE ? 8 : 4, DV = MODE ? 512 : 1024, LD = MODE ? N1 : N0, NC = DV / 512;
    constexpr int VOFF = MODE ? 4096 : 2048, GOFF = VOFF + DI;
    for (int p = gw; p < T * H; p += NGW) {
        const int t = p / H, hh = p % H;
        bf16_t* orow = proj + (size_t)t * LD + VOFF + hh * DV;
        const bf16_t* grow = proj + (size_t)t * LD + GOFF + hh * DV;
        u32x4 ov[NC], gv[NC];
#pragma unroll
        for (int cc = 0; cc < NC; ++cc) { ov[cc] = *(const u32x4*)(orow + cc * 512 + lane * 8); gv[cc] = *(const u32x4*)(grow + cc * 512 + lane * 8); }
        float s1 = 0.f, s2 = 0.f;
#pragma unroll
        for (int cc = 0; cc < NC; ++cc)
#pragma unroll
            for (int q = 0; q < 4; ++q) { const float oa = bflo(ov[cc][q]), ob = bfhi(ov[cc][q]); s1 += oa + ob; s2 += oa * oa + ob * ob; }
        s1 = wave_sum(s1); s2 = wave_sum(s2);
        float mu = 0.f, rs;
        if (MODE == 0) rs = rsqrtf(s2 * (1.0f / DV) + EPS);
        else { mu = s1 * (1.0f / DV); rs = rsqrtf(fmaxf(s2 * (1.0f / DV) - mu * mu, 0.f) + EPS); }
#pragma unroll
        for (int cc = 0; cc < NC; ++cc) {
            const int col = cc * 512 + lane * 8;
            const f32x4 g0 = *(const f32x4*)(gain + hh * DV + col), g1 = *(const f32x4*)(gain + hh * DV + col + 4);
            f32x4 b0 = (f32x4){0.f, 0.f, 0.f, 0.f}, b1 = b0;
            if (MODE == 1) { b0 = *(const f32x4*)(bias + hh * DV + col); b1 = *(const f32x4*)(bias + hh * DV + col + 4); }
            const float gg[8] = {g0[0], g0[1], g0[2], g0[3], g1[0], g1[1], g1[2], g1[3]}, bb[8] = {b0[0], b0[1], b0[2], b0[3], b1[0], b1[1], b1[2], b1[3]};
            u32x4 res;
#pragma unroll
            for (int q = 0; q < 4; ++q) {
                const float oa = bflo(ov[cc][q]), ob = bfhi(ov[cc][q]), ga = bflo(gv[cc][q]), gb = bfhi(gv[cc][q]);
                const float ya = ((oa - mu) * rs * gg[2 * q] + bb[2 * q]) * (ga / (1.0f + __expf(-ga)));
                const float yb = ((ob - mu) * rs * gg[2 * q + 1] + bb[2 * q + 1]) * (gb / (1.0f + __expf(-gb)));
                res[q] = pk2(ya, yb);
            }
            *(u32x4*)(orow + col) = res;
        }
    }
}

__device__ __forceinline__ void p0_transpose_item(const float* W, int K, int N, bf16_t* WT, int row_off, LAS float* scr, int item, int lane, const float* kvec, int sc0, int sc1, float sc) {
    const int nblk = N / 32, kb = item / nblk, nb = item % nblk, k0 = 64 * kb, n0 = 32 * nb;
    const float cs = (n0 >= sc0 && n0 < sc1) ? sc : 1.0f;
#pragma unroll 8
    for (int i = 0; i < 32; ++i) { const int kk = 2 * i + (lane >> 5); const float kv = kvec ? kvec[k0 + kk] : 1.0f; scr[kk * 33 + (lane & 31)] = W[(size_t)(k0 + kk) * N + n0 + (lane & 31)] * (kv * cs); }
    asm volatile("s_waitcnt lgkmcnt(0)" ::: "memory");
    const int c = lane & 7;
#pragma unroll
    for (int j = 0; j < 4; ++j) { const int n = (lane >> 3) + 8 * j; const LAS float* s = scr + (8 * c) * 33 + n;
        u32x4 o; o.x = pk2(s[0 * 33], s[1 * 33]); o.y = pk2(s[2 * 33], s[3 * 33]); o.z = pk2(s[4 * 33], s[5 * 33]); o.w = pk2(s[6 * 33], s[7 * 33]);
        *(u32x4*)(WT + (size_t)(row_off + n0 + n) * K + k0 + 8 * c) = o; }
    asm volatile("s_waitcnt lgkmcnt(0)" ::: "memory");
}

struct Args {
    const float* x; const int* pos;
    const float *gla_norm, *gla_w_in, *gla_w_a1, *gla_w_a2, *gla_b_a, *gla_head_g, *gla_w_out;
    const float *ret_norm, *ret_w_in, *ret_gn_g, *ret_gn_b, *ret_w_out, *final_norm;
    float* out; unsigned char* ws;
};

__global__ void __launch_bounds__(512, 2) fwd(Args a) {
    extern __shared__ __attribute__((aligned(16))) unsigned char lds_raw[];
    LAS unsigned char* lds = (LAS unsigned char*)lds_raw;
    cg::grid_group grid = cg::this_grid();
    const int tid = threadIdx.x, lane = tid & 63, wave = __builtin_amdgcn_readfirstlane(tid >> 6);
    const int G = gridDim.x, bx = blockIdx.x;
    const int vcu = (G % 8 == 0) ? (bx % 8) * (G / 8) + bx / 8 : bx;
    const int gw = vcu * 8 + wave, NGW = G * 8;
    const int gtid = bx * 512 + tid, NGT = G * 512;
    unsigned char* ws = a.ws;
    bf16_t* W0T = (bf16_t*)(ws + WS_W0T); bf16_t* WOUT0T = (bf16_t*)(ws + WS_WOUT0T); bf16_t* W1T = (bf16_t*)(ws + WS_W1T); bf16_t* WOUT1T = (bf16_t*)(ws + WS_WOUT1T);
    bf16_t* H1BF = (bf16_t*)(ws + WS_H1BF); bf16_t* PROJ = (bf16_t*)(ws + WS_PROJ);
    bf16_t* HN = (bf16_t*)a.out;
    f32x2* ROT = (f32x2*)(ws + WS_ROT); float* SUMSQ1 = (float*)(ws + WS_SUMSQ1);

    {
        LAS float* scr = (LAS float*)(lds + wave * 8704);
        constexpr int I_W0 = (D / 64) * (10240 / 32), I_WO = (DI / 64) * (D / 32), I_W1 = (D / 64) * (N1 / 32);
        constexpr int NITEMS = I_W0 + I_WO + I_W1 + I_WO;
        for (int it = gw; it < NITEMS; it += NGW) {
            int q = it;
            if (q < I_W0) { p0_transpose_item(a.gla_w_in, D, 10240, W0T, 0, scr, q, lane, nullptr, 0, 1024, 0.0625f); continue; } q -= I_W0;
            if (q < I_WO) { p0_transpose_item(a.gla_w_out, DI, D, WOUT0T, 0, scr, q, lane, nullptr, 0, 0, 1.0f); continue; } q -= I_WO;
            if (q < I_W1) { p0_transpose_item(a.ret_w_in, D, N1, W1T, 0, scr, q, lane, a.ret_norm, 2048, 4096, 0.0625f); continue; } q -= I_W1;
            p0_transpose_item(a.ret_w_out, DI, D, WOUT1T, 0, scr, q, lane, nullptr, 0, 0, 1.0f);
        }
        for (int idx = gtid; idx < 1024 * 256; idx += NGT) {
            const int n = idx >> 8, kc = idx & 255;
            float a2[16];
#pragma unroll
            for (int rr = 0; rr < 16; ++rr) a2[rr] = a.gla_w_a2[rr * 1024 + n];
            float res[8];
#pragma unroll
            for (int kk = 0; kk < 8; ++kk) {
                const f32x4* p = (const f32x4*)(a.gla_w_a1 + (size_t)(8 * kc + kk) * 16);
                const f32x4 p0 = p[0], p1 = p[1], p2 = p[2], p3 = p[3];
                res[kk] = p0[0] * a2[0] + p0[1] * a2[1] + p0[2] * a2[2] + p0[3] * a2[3] + p1[0] * a2[4] + p1[1] * a2[5] + p1[2] * a2[6] + p1[3] * a2[7]
                        + p2[0] * a2[8] + p2[1] * a2[9] + p2[2] * a2[10] + p2[3] * a2[11] + p3[0] * a2[12] + p3[1] * a2[13] + p3[2] * a2[14] + p3[3] * a2[15];
            }
            *(u32x4*)(W0T + (size_t)(10240 + n) * D + 8 * kc) = (u32x4){pk2(res[0], res[1]), pk2(res[2], res[3]), pk2(res[4], res[5]), pk2(res[6], res[7])};
        }
        for (int m = gw; m < T; m += NGW) {
            const f32x4* xr = (const f32x4*)(a.x + (size_t)m * D) + lane;
            const f32x4* gr = (const f32x4*)a.gla_norm + lane;
            f32x4 v[8]; float s = 0.f;
#pragma unroll
            for (int j = 0; j < 8; ++j) { v[j] = xr[64 * j]; s += (v[j][0] * v[j][0] + v[j][1] * v[j][1]) + (v[j][2] * v[j][2] + v[j][3] * v[j][3]); }
            const float rs = rsqrtf(wave_sum(s) * (1.0f / D) + EPS);
            u32x2* o8 = (u32x2*)(HN + (size_t)m * D) + lane;
#pragma unroll
            for (int j = 0; j < 8; ++j) { const f32x4 g = gr[64 * j]; o8[64 * j] = (u32x2){pk2(v[j][0] * rs * g[0], v[j][1] * rs * g[1]), pk2(v[j][2] * rs * g[2], v[j][3] * rs * g[3])}; }
        }
    }
    grid.sync();
    {
        pg8::Gemm g{HN, W0T, T, N0, D, D}; pg8::StaticOrder S; S.init(T, N0, G, bx);
        pg8::EpiProj E{PROJ, N0, 0, nullptr, a.gla_b_a, nullptr};
        pg8::gemm_phase<pg8::EpiProj>(lds, g, S, E);
    }
    grid.sync();
    scan_phase<0>(lds, PROJ, vcu, G);
    grid.sync();
    {
        ew_phase<0>(PROJ, a.gla_head_g, nullptr, gw, NGW, lane);
        for (int idx = gtid; idx < T * 128; idx += NGT) {
            const int t = idx >> 7, i = idx & 127;
            const double invf = exp(-(double)i * (9.210340371976184 / 128.0));
            const double ang = (double)a.pos[t] * invf;
            double rev = ang * 0.15915494309189535; rev -= floor(rev);
            const float fr = (float)rev;
            ROT[idx] = (f32x2){__builtin_amdgcn_cosf(fr), __builtin_amdgcn_sinf(fr)};
        }
        for (int idx = gtid; idx < T; idx += NGT) SUMSQ1[idx] = 0.f;
    }
    grid.sync();
    {
        pg8::Gemm g{PROJ + 2048, WOUT0T, T, D, DI, N0}; pg8::StaticOrder S; S.init(T, D, G, bx);
        pg8::EpiOut E{a.x, a.out, H1BF, SUMSQ1};
        pg8::gemm_phase<pg8::EpiOut>(lds, g, S, E);
    }
    grid.sync();
    {
        pg8::Gemm g{H1BF, W1T, T, N1, D, D}; pg8::StaticOrder S; S.init(T, N1, G, bx);
        pg8::EpiProj E{PROJ, N1, 1, SUMSQ1, nullptr, ROT};
        pg8::gemm_phase<pg8::EpiProj>(lds, g, S, E);
    }
    grid.sync();
    scan_phase<1>(lds, PROJ, vcu, G);
    grid.sync();
    ew_phase<1>(PROJ, a.ret_gn_g, a.ret_gn_b, gw, NGW, lane);
    grid.sync();
    {
        pg8::Gemm g{PROJ + 4096, WOUT1T, T, D, DI, N1}; pg8::StaticOrder S; S.init(T, D, G, bx);
        pg8::EpiOut E{a.out, a.out, nullptr, nullptr};
        pg8::gemm_phase<pg8::EpiOut>(lds, g, S, E);
    }
    grid.sync();
    for (int m = gw; m < T; m += NGW) {
        f32x4* xr = (f32x4*)(a.out + (size_t)m * D) + lane;
        const f32x4* gr = (const f32x4*)a.final_norm + lane;
        f32x4 v[8]; float s = 0.f;
#pragma unroll
        for (int j = 0; j < 8; ++j) { v[j] = xr[64 * j]; s += (v[j][0] * v[j][0] + v[j][1] * v[j][1]) + (v[j][2] * v[j][2] + v[j][3] * v[j][3]); }
        const float rs = rsqrtf(wave_sum(s) * (1.0f / D) + EPS);
#pragma unroll
        for (int j = 0; j < 8; ++j) xr[64 * j] = v[j] * rs * gr[64 * j];
    }
}

extern "C" void kernel_launch(void* const* d_in, const int* in_sizes, int n_in, void* d_out, int out_size, void* d_ws, size_t ws_size, hipStream_t stream) {
    static int grid = 0;
    if (grid == 0) {
        int dev = 0, cus = 0, per_cu = 0;
        (void)hipGetDevice(&dev);
        (void)hipDeviceGetAttribute(&cus, hipDeviceAttributeMultiprocessorCount, dev);
        (void)hipFuncSetAttribute((const void*)fwd, hipFuncAttributeMaxDynamicSharedMemorySize, LDS_BYTES);
        (void)hipOccupancyMaxActiveBlocksPerMultiprocessor(&per_cu, (const void*)fwd, 512, LDS_BYTES);
        if (per_cu < 1) per_cu = 1;
        grid = cus * per_cu;
        if (ws_size < 1024 * MiB) fprintf(stderr, "kernel_launch: workspace too small (%zu)\n", ws_size);
    }
    Args a{};
    a.x = (const float*)d_in[0]; a.pos = (const int*)d_in[1];
    a.gla_norm = (const float*)d_in[2]; a.gla_w_in = (const float*)d_in[3]; a.gla_w_a1 = (const float*)d_in[4]; a.gla_w_a2 = (const float*)d_in[5];
    a.gla_b_a = (const float*)d_in[6]; a.gla_head_g = (const float*)d_in[7]; a.gla_w_out = (const float*)d_in[8];
    a.ret_norm = (const float*)d_in[9]; a.ret_w_in = (const float*)d_in[10]; a.ret_gn_g = (const float*)d_in[11]; a.ret_gn_b = (const float*)d_in[12];
    a.ret_w_out = (const float*)d_in[13]; a.final_norm = (const float*)d_in[14];
    a.out = (float*)d_out; a.ws = (unsigned char*)d_ws;
    void* args[] = {&a};
    hipError_t e = hipLaunchCooperativeKernel((const void*)fwd, dim3(grid), dim3(512), args, LDS_BYTES, stream);
    if (e != hipSuccess) fprintf(stderr, "cooperative launch failed: %s (grid %d)\n", hipGetErrorString(e), grid);
}
```

```cpp
#include <hip/hip_runtime.h>
#include <hip/hip_cooperative_groups.h>
#include <cstdio>
#include <cstdint>
namespace cg = cooperative_groups;

#define LAS __attribute__((address_space(3)))
typedef unsigned short bf16_t;
typedef short bf16x8 __attribute__((ext_vector_type(8)));
typedef short s16x4 __attribute__((ext_vector_type(4)));
typedef float f32x4 __attribute__((ext_vector_type(4)));
typedef float f32x2 __attribute__((ext_vector_type(2)));
typedef float f32x16 __attribute__((ext_vector_type(16)));
typedef unsigned u32x4 __attribute__((ext_vector_type(4)));
typedef unsigned u32x2 __attribute__((ext_vector_type(2)));
typedef __bf16 bf2_t __attribute__((ext_vector_type(2)));

constexpr int T = 32768, D = 2048, DI = 4096, SEQ = 4096;
constexpr int N0 = 11264, N1 = 12288;
constexpr float EPS = 1e-6f;
constexpr size_t MiB = 1u << 20;
constexpr size_t WS_W0T = 0, WS_WOUT0T = 44 * MiB, WS_W1T = 64 * MiB, WS_WOUT1T = 112 * MiB, WS_H1BF = 128 * MiB, WS_PROJ = 256 * MiB;
constexpr size_t WS_ROT = 0, WS_SUMSQ1 = 32 * MiB;
constexpr int LDS_BYTES = 155648, LDS_BARW = 155584;
constexpr size_t WS_BAR = 60 * MiB, WS_BAR_BYTES = 16384;

__device__ __forceinline__ unsigned pk2(float lo, float hi) { bf2_t r = __builtin_convertvector((f32x2){lo, hi}, bf2_t); return __builtin_bit_cast(unsigned, r); }
__device__ __forceinline__ float bflo(unsigned u) { return __builtin_bit_cast(float, u << 16); }
__device__ __forceinline__ float bfhi(unsigned u) { return __builtin_bit_cast(float, u & 0xffff0000u); }
__device__ __forceinline__ float wave_sum(float v) {
#pragma unroll
    for (int o = 1; o < 64; o <<= 1) v += __shfl_xor(v, o);
    return v;
}

namespace pg8 {
constexpr int BM = 256, BK = 64, HALF = 128, HTB = HALF * BK * 2, STAGE_BYTES = 8 * HTB, NXCD = 8, WGM = 8;
__host__ __device__ __forceinline__ int lds_byte(int r, int c) { const int st = (r >> 4) * 2 + (c >> 5), rr = r & 15, cc = c & 31, ob = rr * 64 + cc * 2; return st * 1024 + (ob ^ (((ob >> 9) & 1) << 5)); }
__host__ __device__ __forceinline__ void stage_rc(int b, int& R, int& C) { const int st = b / 1024, sb = b % 1024, swz = sb ^ (((sb >> 9) & 1) << 5); R = (st >> 1) * 16 + swz / 64; C = (st & 1) * 32 + (swz % 64) / 2; }
__host__ __device__ __forceinline__ int perm32(int rho) { const int n = rho >> 4, i = rho & 15; return 8 * (i >> 2) + 4 * n + (i & 3); }

struct Unit { int pm, pn; };
struct Gemm { const bf16_t* A; const bf16_t* Bt; int M, N, K, lda; };

struct StaticOrder {
    int nM, nN, nwg, G, c;
    __device__ void init(int M, int N, int G_, int c_) { nM = M / BM; nN = N / BM; nwg = nM * nN; G = G_; c = c_; }
    __device__ bool next(int i, Unit& u) const {
        const long L = (long)i * G + c; if (L >= nwg) return false;
        int wgid = (int)L; { const int q = nwg / NXCD, r = nwg % NXCD, xcd = wgid % NXCD, off = wgid / NXCD; wgid = (xcd < r ? xcd * (q + 1) : r * (q + 1) + (xcd - r) * q) + off; }
        const int nig = WGM * nN, gid = wgid / nig, fm = gid * WGM, gsz = (nM - fm) < WGM ? (nM - fm) : WGM;
        u.pm = fm + ((wgid % nig) % gsz); u.pn = (wgid % nig) / gsz; return true;
    }
};


struct EpiProj {
    static constexpr bool PERM = true;
    bf16_t* O; int ldc; int mode;
    const float* rowsumsq;
    const float* b_a;
    const f32x2* rot;
    __device__ __forceinline__ void operator()(const f32x4 (&acc)[2][2][4][2], const Unit& u, int wr, int wc, int fr, int fq) const {
        const int row0 = u.pm * BM + wr * 64 + fr, col0 = u.pn * BM + wc * 32 + 8 * fq;
        const bool is_a = (mode == 0) && (u.pn >= 40);
        const bool is_rot = (mode == 1) && (u.pn < 16);
        f32x4 bv[2][2];
#pragma unroll
        for (int bj = 0; bj < 2; ++bj)
#pragma unroll
            for (int n = 0; n < 2; ++n) bv[bj][n] = is_a ? *(const f32x4*)(b_a + (col0 - 10240) + bj * HALF + 4 * n) : (f32x4){0.f, 0.f, 0.f, 0.f};
#pragma unroll
        for (int ai = 0; ai < 2; ++ai)
#pragma unroll
            for (int m = 0; m < 4; ++m) {
                const int row = row0 + ai * HALF + m * 16;
                const float rs = rowsumsq ? rsqrtf(rowsumsq[row] * (1.0f / D) + EPS) : 1.0f;
                f32x4 v[2][2];
#pragma unroll
                for (int bj = 0; bj < 2; ++bj)
#pragma unroll
                    for (int n = 0; n < 2; ++n) v[bj][n] = acc[ai][bj][m][n] * rs;
                if (is_a) {
#pragma unroll
                    for (int bj = 0; bj < 2; ++bj)
#pragma unroll
                        for (int n = 0; n < 2; ++n)
#pragma unroll
                            for (int j = 0; j < 4; ++j) { const float x = v[bj][n][j] + bv[bj][n][j]; v[bj][n][j] = (fminf(x, 0.f) - __logf(1.0f + __expf(-fabsf(x)))) * (1.0f / 16.0f); }
                }
                if (is_rot) {
                    const f32x2* rp = rot + (size_t)row * 128 + wc * 32 + 8 * fq;
#pragma unroll
                    for (int n = 0; n < 2; ++n) {
                        const f32x4 t0 = *(const f32x4*)(rp + 4 * n), t1 = *(const f32x4*)(rp + 4 * n + 2);
                        const float cs[4] = {t0[0], t0[2], t1[0], t1[2]}, sn[4] = {t0[1], t0[3], t1[1], t1[3]};
#pragma unroll
                        for (int j = 0; j < 4; ++j) { const float x1 = v[0][n][j], x2 = v[1][n][j]; v[0][n][j] = x1 * cs[j] - x2 * sn[j]; v[1][n][j] = x2 * cs[j] + x1 * sn[j]; }
                    }
                }
                bf16_t* rowp = O + (size_t)row * ldc + col0;
#pragma unroll
                for (int bj = 0; bj < 2; ++bj) {
                    u32x4 w; w.x = pk2(v[bj][0][0], v[bj][0][1]); w.y = pk2(v[bj][0][2], v[bj][0][3]); w.z = pk2(v[bj][1][0], v[bj][1][1]); w.w = pk2(v[bj][1][2], v[bj][1][3]);
                    *(u32x4*)(rowp + bj * HALF) = w;
                }
            }
    }
};
struct EpiOut {
    static constexpr bool PERM = true;
    const float* resid32; const bf16_t* resid16; bf16_t* out16; float* sumsq;
    __device__ __forceinline__ void operator()(const f32x4 (&acc)[2][2][4][2], const Unit& u, int wr, int wc, int fr, int fq) const {
        const int row0 = u.pm * BM + wr * 64 + fr, col0 = u.pn * BM + wc * 32 + 8 * fq;
#pragma unroll
        for (int ai = 0; ai < 2; ++ai)
#pragma unroll
            for (int m = 0; m < 4; ++m) {
                const int row = row0 + ai * HALF + m * 16;
                const size_t off = (size_t)row * D + col0;
                float ss = 0.f;
#pragma unroll
                for (int bj = 0; bj < 2; ++bj) {
                    f32x4 r0, r1;
                    if (resid32) { r0 = __builtin_nontemporal_load((const f32x4*)(resid32 + off + bj * HALF)); r1 = __builtin_nontemporal_load((const f32x4*)(resid32 + off + bj * HALF + 4)); }
                    else { const u32x4 rr = *(const u32x4*)(resid16 + off + bj * HALF);
                           r0 = (f32x4){bflo(rr.x), bfhi(rr.x), bflo(rr.y), bfhi(rr.y)}; r1 = (f32x4){bflo(rr.z), bfhi(rr.z), bflo(rr.w), bfhi(rr.w)}; }
                    const f32x4 v0 = acc[ai][bj][m][0] + r0, v1 = acc[ai][bj][m][1] + r1;
                    ss += ((v0[0] * v0[0] + v0[1] * v0[1]) + (v0[2] * v0[2] + v0[3] * v0[3])) + ((v1[0] * v1[0] + v1[1] * v1[1]) + (v1[2] * v1[2] + v1[3] * v1[3]));
                    u32x4 w; w.x = pk2(v0[0], v0[1]); w.y = pk2(v0[2], v0[3]); w.z = pk2(v1[0], v1[1]); w.w = pk2(v1[2], v1[3]);
                    *(u32x4*)(out16 + off + bj * HALF) = w;
                }
                if (sumsq) { ss += __shfl_xor(ss, 16); ss += __shfl_xor(ss, 32); if (fq == 0) atomicAdd(sumsq + row, ss); }
            }
    }
};

template <class Epi>
__device__ __forceinline__ void gemm_phase(LAS unsigned char* lds, const Gemm g, const StaticOrder& S, const Epi& E) {
    const int tid = threadIdx.x, wid = __builtin_amdgcn_readfirstlane(tid >> 6), lane = tid & 63, wr = wid >> 2, wc = wid & 3, fr = lane & 15, fq = lane >> 4;
    const int K = g.K, nt = K / BK, lda = g.lda;
    unsigned voffA[2], voffB[2];
#pragma unroll
    for (int i = 0; i < 2; ++i) { int R, C; stage_rc(tid * 16 + i * 8192, R, C); const int Rb = Epi::PERM ? ((R & ~31) + perm32(R & 31)) : R;
        voffA[i] = (unsigned)(R * lda + C) * 2u; voffB[i] = (unsigned)(Rb * K + C) * 2u; }
    const size_t kstep = (size_t)(BK * 2);
    const size_t hstepA = (size_t)HALF * lda * 2, hstepB = (size_t)HALF * K * 2;
    const size_t tstepA = 2 * hstepA, tstepB = 2 * hstepB;
    const unsigned ldsw = (unsigned)wid * 1024u;
    const int aoff = lds_byte(wr * 64 + fr, fq * 8), boff = lds_byte(wc * 32 + fr, fq * 8);
#define PG8_SA(b, h) (((b) * 2 + (h)) * HTB)
#define PG8_SB(b, h) ((4 + (b) * 2 + (h)) * HTB)
#define PG8_STAGE(bufoff, gbase, voff) do { _Pragma("unroll") for (int _i = 0; _i < 2; ++_i) \
        __builtin_amdgcn_global_load_lds((const unsigned*)((const char*)(gbase) + (voff)[_i]), (LAS unsigned*)(lds + (bufoff) + ldsw + _i * 8192), 16, 0, 0); } while (0)
#define PG8_LDA(dst, b, h) do { _Pragma("unroll") for (int m = 0; m < 4; ++m) _Pragma("unroll") for (int k = 0; k < 2; ++k) dst[m][k] = *(const LAS bf16x8*)(lds + PG8_SA(b, h) + aoff + m * 2048 + k * 1024); } while (0)
#define PG8_LDB(dst, b, h) do { _Pragma("unroll") for (int n = 0; n < 2; ++n) _Pragma("unroll") for (int k = 0; k < 2; ++k) dst[n][k] = *(const LAS bf16x8*)(lds + PG8_SB(b, h) + boff + n * 2048 + k * 1024); } while (0)
#define PG8_MMA(ai, bj, At, Bt) do { __builtin_amdgcn_s_setprio(1); _Pragma("unroll") for (int m = 0; m < 4; ++m) _Pragma("unroll") for (int n = 0; n < 2; ++n) _Pragma("unroll") for (int k = 0; k < 2; ++k) \
        acc[ai][bj][m][n] = __builtin_amdgcn_mfma_f32_16x16x32_bf16(Bt[n][k], At[m][k], acc[ai][bj][m][n], 0, 0, 0); __builtin_amdgcn_s_setprio(0); } while (0)
#define PG8_WAIT_V(n) asm volatile("s_waitcnt vmcnt(" #n ")" ::: "memory")
#define PG8_WAIT_L(n) asm volatile("s_waitcnt lgkmcnt(" #n ")" ::: "memory")
#define PG8_BAR __builtin_amdgcn_s_barrier()
#define PG8_SCHED __builtin_amdgcn_sched_barrier(0)
    Unit cur, nxt; int ui = 0;
    if (!S.next(0, cur)) return;
    f32x4 acc[2][2][4][2];
#pragma unroll
    for (int a = 0; a < 2; ++a)
#pragma unroll
        for (int b = 0; b < 2; ++b)
#pragma unroll
            for (int m = 0; m < 4; ++m)
#pragma unroll
                for (int n = 0; n < 2; ++n) acc[a][b][m][n] = (f32x4){0.f, 0.f, 0.f, 0.f};
    bf16x8 At[4][2], B0[2][2], B1[2][2];
    const char* cA = (const char*)g.A + (size_t)cur.pm * tstepA; const char* cB = (const char*)g.Bt + (size_t)cur.pn * tstepB;
    PG8_STAGE(PG8_SB(0, 0), cB, voffB); PG8_STAGE(PG8_SB(0, 1), cB + hstepB, voffB); PG8_STAGE(PG8_SA(0, 0), cA, voffA); PG8_STAGE(PG8_SA(0, 1), cA + hstepA, voffA);
    if (wr == 1) PG8_BAR;
    PG8_WAIT_V(2); PG8_BAR;
    PG8_STAGE(PG8_SB(1, 0), cB + kstep, voffB); PG8_STAGE(PG8_SA(1, 0), cA + kstep, voffA); PG8_STAGE(PG8_SB(1, 1), cB + hstepB + kstep, voffB);
    PG8_WAIT_V(6); PG8_BAR;
    for (;;) {
        const bool has_next = S.next(ui + 1, nxt);
        const char* nA = has_next ? (const char*)g.A + (size_t)nxt.pm * tstepA : cA; const char* nB = has_next ? (const char*)g.Bt + (size_t)nxt.pn * tstepB : cB;
        for (int t = 0; t < nt; t += 2) {
            const bool last = (t == nt - 2);
            const char* a1 = cA + (size_t)(t + 1) * kstep;
            const char* a2 = last ? nA : cA + (size_t)(t + 2) * kstep; const char* b2 = last ? nB : cB + (size_t)(t + 2) * kstep;
            const char* a3 = a2 + kstep; const char* b3 = b2 + kstep;
            PG8_LDB(B0, 0, 0); PG8_LDB(B1, 0, 1); PG8_SCHED; PG8_LDA(At, 0, 0); PG8_STAGE(PG8_SA(1, 1), a1 + hstepA, voffA);
            PG8_WAIT_V(8); PG8_WAIT_L(0); PG8_BAR; PG8_MMA(0, 0, At, B0); PG8_MMA(0, 1, At, B1); PG8_BAR; PG8_SCHED;
            PG8_LDA(At, 0, 1); PG8_STAGE(PG8_SB(0, 0), b2, voffB); PG8_STAGE(PG8_SB(0, 1), b2 + hstepB, voffB); PG8_STAGE(PG8_SA(0, 0), a2, voffA);
            PG8_WAIT_V(8); PG8_WAIT_L(0); PG8_BAR; PG8_MMA(1, 0, At, B0); PG8_MMA(1, 1, At, B1); PG8_BAR; PG8_SCHED;
            PG8_LDB(B0, 1, 0); PG8_LDB(B1, 1, 1); PG8_SCHED; PG8_LDA(At, 1, 0); PG8_STAGE(PG8_SA(0, 1), a2 + hstepA, voffA);
            PG8_WAIT_V(8); PG8_WAIT_L(0); PG8_BAR; PG8_MMA(0, 0, At, B0); PG8_MMA(0, 1, At, B1); PG8_BAR; PG8_SCHED;
            PG8_LDA(At, 1, 1); PG8_STAGE(PG8_SB(1, 0), b3, voffB); PG8_STAGE(PG8_SB(1, 1), b3 + hstepB, voffB); PG8_STAGE(PG8_SA(1, 0), a3, voffA);
            PG8_WAIT_V(8); PG8_WAIT_L(0); PG8_BAR; PG8_MMA(1, 0, At, B0); PG8_MMA(1, 1, At, B1); PG8_BAR; PG8_SCHED;
        }
        if (wr == 0) PG8_BAR;
        E(acc, cur, wr, wc, fr, fq);
        if (!has_next) break;
#pragma unroll
        for (int a = 0; a < 2; ++a)
#pragma unroll
            for (int b = 0; b < 2; ++b)
#pragma unroll
                for (int m = 0; m < 4; ++m)
#pragma unroll
                    for (int n = 0; n < 2; ++n) acc[a][b][m][n] = (f32x4){0.f, 0.f, 0.f, 0.f};
        cur = nxt; cA = nA; cB = nB; ++ui;
        if (wr == 1) PG8_BAR;
    }
    PG8_WAIT_V(0);
    PG8_BAR;
#undef PG8_SA
#undef PG8_SB
#undef PG8_STAGE
#undef PG8_LDA
#undef PG8_LDB
#undef PG8_MMA
#undef PG8_WAIT_V
#undef PG8_WAIT_L
#undef PG8_BAR
#undef PG8_SCHED
}
}

constexpr int QT_OFF = 0, KH_OFF = 33792, KT_OFF = 67584, VT_OFF = 104448, PB_OFF = 122880, EV_OFF = 132096, TOT_OFF = 133120;
constexpr int QSTR = 264, TSTR = 72;
#define MFMA32(a, b, c) __builtin_amdgcn_mfma_f32_32x32x16_bf16((a), (b), (c), 0, 0, 0)
__device__ __forceinline__ int crow(int i, int h) { return (i & 3) + 8 * (i >> 2) + 4 * h; }

template <int MODE>
__device__ __forceinline__ void prescan_phase(LAS unsigned char* lds, bf16_t* proj, unsigned char* pf_ext, int vcu, int G) {
    constexpr int H = MODE ? 8 : 4, LD = MODE ? N1 : N0, KOFF = MODE ? 2048 : 1024, AOFF = 10240, NIT = 8 * H * 64;
    const int tid = threadIdx.x, lane = tid & 63, w = __builtin_amdgcn_readfirstlane(tid >> 6);
    const int r = lane & 31, h2 = lane >> 5;
    const int cp = tid & 127, sq = w >> 1;
    LAS float* EV = (LAS float*)(lds + EV_OFF);
    LAS float* TOT = (LAS float*)(lds + TOT_OFF);
    const unsigned qlo = ((unsigned)(16 * sq) * LD + 2 * cp) * 2u;
    const unsigned flo = (unsigned)h2 * (LD * 2) + r * 16;
    unsigned rq[16], rk[16], ra[16];
#define PRE_BASE(it) (proj + ((size_t)((it) / (64 * H)) * SEQ + (size_t)((it) % 64) * 64) * LD + (((it) / 64) % H) * 256)
#define PRE_LOAD(it) do { const char* _p = (const char*)PRE_BASE(it); \
        _Pragma("unroll") for (int i = 0; i < 16; ++i) { const char* _pi = _p + (size_t)i * (LD * 2); \
            rq[i] = __builtin_nontemporal_load((const unsigned*)(_pi + qlo)); rk[i] = __builtin_nontemporal_load((const unsigned*)(_pi + KOFF * 2 + qlo)); \
            if (MODE == 0) ra[i] = __builtin_nontemporal_load((const unsigned*)(_pi + AOFF * 2 + qlo)); } } while (0)
    if (vcu < NIT) PRE_LOAD(vcu);
    for (int item = vcu; item < NIT; item += G) {
        const int hh = (item / 64) % H;
        char* qseg = (char*)PRE_BASE(item);
        const float lg = MODE ? log1pf(-exp2f(-5.0f - (float)hh)) : 0.f;
        float run0 = 0.f, run1 = 0.f;
        if (MODE == 0) {
            float a0 = 0.f, a1 = 0.f;
#pragma unroll
            for (int i = 0; i < 16; ++i) { a0 += bflo(ra[i]); a1 += bfhi(ra[i]); }
            *(LAS f32x2*)(TOT + sq * 256 + 2 * cp) = (f32x2){a0, a1};
        }
        __syncthreads();
        float lgc = lg;
        if (MODE == 0) {
#pragma unroll
            for (int q = 0; q < 3; ++q) if (q < sq) { const f32x2 t = *(LAS f32x2*)(TOT + q * 256 + 2 * cp); run0 += t[0]; run1 += t[1]; }
        } else {
            asm volatile("" : "+v"(lgc));
        }
#pragma unroll
        for (int hf = 0; hf < 2; ++hf) {
            unsigned kt0[4], kt1[4];
#pragma unroll
            for (int ii = 0; ii < 8; ii += 2) {
                float ka[2], kb2[2];
#pragma unroll
                for (int d = 0; d < 2; ++d) {
                    const int i = 8 * hf + ii + d, s = 16 * sq + i;
                    float cu0, cu1;
                    if (MODE == 0) { run0 += bflo(ra[i]); run1 += bfhi(ra[i]); cu0 = run0; cu1 = run1; }
                    else { cu0 = lgc * (float)(s + 1); cu1 = cu0; }
                    const float e0 = __expf(cu0), e1 = __expf(cu1), f0 = __expf(-cu0), f1 = __expf(-cu1);
                    *(LAS unsigned*)(lds + QT_OFF + (s * QSTR + 2 * cp) * 2) = pk2(bflo(rq[i]) * e0, bfhi(rq[i]) * e1);
                    ka[d] = bflo(rk[i]) * f0; kb2[d] = bfhi(rk[i]) * f1;
                    *(LAS unsigned*)(lds + KH_OFF + (s * QSTR + 2 * cp) * 2) = pk2(ka[d], kb2[d]);
                    if (MODE == 0 && i == 15 && sq == 3) *(LAS f32x2*)(EV + 2 * cp) = (f32x2){e0, e1};
                }
                kt0[ii >> 1] = pk2(ka[0], ka[1]); kt1[ii >> 1] = pk2(kb2[0], kb2[1]);
            }
            LAS unsigned char* kt = lds + KT_OFF + ((2 * cp) * TSTR + 16 * sq + 8 * hf) * 2;
            *(LAS u32x4*)(kt) = (u32x4){kt0[0], kt0[1], kt0[2], kt0[3]};
            *(LAS u32x4*)(kt + TSTR * 2) = (u32x4){kt1[0], kt1[1], kt1[2], kt1[3]};
        }
        __syncthreads();
        if (item + G < NIT) PRE_LOAD(item + G);
        if (w < 3) {
            const int tb = (w >= 1) ? 1 : 0, sb = (w == 2) ? 1 : 0;
            f32x16 P;
#pragma unroll
            for (int i = 0; i < 16; ++i) P[i] = 0.f;
            const LAS unsigned char* qa = lds + QT_OFF + ((32 * tb + r) * QSTR + 8 * h2) * 2;
            const LAS unsigned char* kb_ = lds + KH_OFF + ((32 * sb + r) * QSTR + 8 * h2) * 2;
#pragma unroll
            for (int st = 0; st < 16; ++st) P = MFMA32(*(const LAS bf16x8*)(qa + st * 32), *(const LAS bf16x8*)(kb_ + st * 32), P);
            LAS bf16_t* pb = (LAS bf16_t*)(lds + PB_OFF);
#pragma unroll
            for (int i = 0; i < 16; ++i) {
                const int tr = crow(i, h2);
                const float pv = (tb == sb && r > tr) ? 0.f : P[i];
                pb[(32 * tb + tr) * TSTR + 32 * sb + r] = (bf16_t)(pk2(pv, 0.f) & 0xffffu);
            }
        }
#pragma unroll
        for (int i = 0; i < 4; ++i) {
            const int f = 4 * w + i, tb = f & 1, st = (f >> 1) & 1, kb = f >> 2;
            const LAS unsigned char* q0 = lds + QT_OFF + ((32 * tb + r) * QSTR + 32 * kb + 16 * st + 4 * h2) * 2;
            const u32x2 lo = *(const LAS u32x2*)(q0), hi = *(const LAS u32x2*)(q0 + 16);
            *(u32x4*)(qseg + (size_t)(2 * f) * (LD * 2) + flo) = (u32x4){lo.x, lo.y, hi.x, hi.y};
        }
#pragma unroll
        for (int i = 0; i < 4; ++i) {
            const int f = 4 * w + i, st = i, kb = w;
            const u32x4 kv = *(const LAS u32x4*)(lds + KT_OFF + ((32 * kb + r) * TSTR + 16 * st + 8 * h2) * 2);
            *(u32x4*)(qseg + KOFF * 2 + (size_t)(2 * f) * (LD * 2) + flo) = kv;
        }
        __syncthreads();
        if (w != 2 && w != 3) {
            const int tb = w >> 2, st = w & 3;
            const u32x4 pv = *(const LAS u32x4*)(lds + PB_OFF + ((32 * tb + r) * TSTR + 16 * st + 8 * h2) * 2);
            if (MODE == 0) *(u32x4*)(qseg + AOFF * 2 + (size_t)(2 * w) * (LD * 2) + flo) = pv;
            else *(u32x4*)(pf_ext + (size_t)item * 8192 + w * 1024 + lane * 16) = pv;
        } else if (MODE == 0 && w == 2) {
            const f32x4 ev = *(const LAS f32x4*)(EV + 4 * lane);
            *(f32x4*)(qseg + AOFF * 2 + (size_t)16 * (LD * 2) + flo) = ev;
        }
    }
#undef PRE_LOAD
#undef PRE_BASE
    __syncthreads();
}

constexpr int QB_OFF = 0, KB_OFF = 32768, VT2_OFF = 98304, EV2_OFF = 116736, XCH_OFF = 118784;
template <int MODE>
__device__ __forceinline__ void scan_phase(LAS unsigned char* lds, bf16_t* proj, const unsigned char* pf_ext, int vcu, int G) {
    constexpr int H = MODE ? 8 : 4, DV = MODE ? 512 : 1024, NSL = DV / 128, LD = MODE ? N1 : N0;
    constexpr int KOFF = MODE ? 2048 : 1024, VOFF = MODE ? 4096 : 2048, AOFF = 10240;
    const int tid = threadIdx.x, lane = tid & 63, w = __builtin_amdgcn_readfirstlane(tid >> 6);
    const int r = lane & 31, h2 = lane >> 5, vb = w & 3, kh = w >> 2;
    const int vp = lane, s8 = w;
    LAS float* XCH = (LAS float*)(lds + XCH_OFF);
    const unsigned flo = (unsigned)h2 * (LD * 2) + r * 16;
    const unsigned vlo = ((unsigned)(8 * s8) * LD + 2 * vp) * 2u;
    for (int item = vcu; item < 256; item += G) {
        const int vs = item % NSL, hh = (item / NSL) % H, b = item / (NSL * H);
        const size_t rowb = (size_t)b * SEQ;
        const char* qseg0 = (const char*)(proj + rowb * LD + hh * 256);
        bf16_t* vbase = proj + rowb * LD + VOFF + hh * DV + vs * 128;
        const unsigned char* pfb = pf_ext + (size_t)((b * H + hh) * 64) * 8192;
        const float gdec = MODE ? __expf(64.0f * log1pf(-exp2f(-5.0f - (float)hh))) : 1.0f;
        f32x16 S[4];
#pragma unroll
        for (int j = 0; j < 4; ++j)
#pragma unroll
            for (int i = 0; i < 16; ++i) S[j][i] = 0.f;
        unsigned rv[8]; u32x4 pf[4]; f32x16 oprev;
#define SC_SEG(c) (qseg0 + (size_t)((c) * 64) * (LD * 2))
#define SC_DMA(c) do { const char* _s = SC_SEG(c); const int _b = (c) & 1; \
            _Pragma("unroll") for (int i = 0; i < 4; ++i) __builtin_amdgcn_global_load_lds((const unsigned*)(_s + KOFF * 2 + (size_t)(2 * (4 * w + i)) * (LD * 2) + flo), (LAS unsigned*)(lds + KB_OFF + _b * 32768 + (4 * w + i) * 1024), 16, 0, 0); \
            _Pragma("unroll") for (int i = 0; i < 4; ++i) __builtin_amdgcn_global_load_lds((const unsigned*)(_s + (size_t)(2 * (4 * w + i)) * (LD * 2) + flo), (LAS unsigned*)(lds + QB_OFF + (4 * w + i) * 1024), 16, 0, 0); \
            if (MODE == 0 && w == 0) __builtin_amdgcn_global_load_lds((const unsigned*)(_s + AOFF * 2 + (size_t)16 * (LD * 2) + flo), (LAS unsigned*)(lds + EV2_OFF + _b * 1024), 16, 0, 0); } while (0)
#define SC_LOADV(c) do { const char* _v = (const char*)(vbase + (size_t)((c) * 64) * LD); \
            _Pragma("unroll") for (int i = 0; i < 8; ++i) rv[i] = __builtin_nontemporal_load((const unsigned*)(_v + (size_t)i * (LD * 2) + vlo)); } while (0)
#define SC_LOADP(c) do { _Pragma("unroll") for (int st = 0; st < 4; ++st) if (st < 2 || kh) { \
            if (MODE == 0) pf[st] = *(const u32x4*)(SC_SEG(c) + AOFF * 2 + (size_t)(2 * (4 * kh + st)) * (LD * 2) + flo); \
            else pf[st] = *(const u32x4*)(pfb + (size_t)(c) * 8192 + (4 * kh + st) * 1024 + lane * 16); } } while (0)
        SC_DMA(0); SC_LOADV(0); SC_LOADP(0);
        for (int c = 0; c < 64; ++c) {
            {
                u32x4 v0, v1;
                v0.x = (rv[0] & 0xffffu) | (rv[1] << 16); v0.y = (rv[2] & 0xffffu) | (rv[3] << 16); v0.z = (rv[4] & 0xffffu) | (rv[5] << 16); v0.w = (rv[6] & 0xffffu) | (rv[7] << 16);
                v1.x = (rv[0] >> 16) | (rv[1] & 0xffff0000u); v1.y = (rv[2] >> 16) | (rv[3] & 0xffff0000u); v1.z = (rv[4] >> 16) | (rv[5] & 0xffff0000u); v1.w = (rv[6] >> 16) | (rv[7] & 0xffff0000u);
                LAS unsigned char* vt = lds + VT2_OFF + ((2 * vp) * TSTR + 8 * s8) * 2;
                *(LAS u32x4*)(vt) = v0; *(LAS u32x4*)(vt + TSTR * 2) = v1;
            }
            asm volatile("s_waitcnt vmcnt(0)" ::: "memory");
            __syncthreads();
            if (c > 0) {
                char* op = (char*)(vbase + (size_t)((c - 1) * 64 + 32 * kh) * LD);
                const unsigned olo = ((unsigned)(4 * h2) * LD + 32 * vb + r) * 2u;
#pragma unroll
                for (int i = 0; i < 16; ++i) __builtin_nontemporal_store((bf16_t)(pk2(oprev[i], 0.f) & 0xffffu), (bf16_t*)(op + (size_t)((i & 3) + 8 * (i >> 2)) * (LD * 2) + olo));
            }
            if (c + 1 < 64) SC_LOADV(c + 1);
            f32x16 op0, op1;
#pragma unroll
            for (int i = 0; i < 16; ++i) { op0[i] = 0.f; op1[i] = 0.f; }
#pragma unroll
            for (int j = 0; j < 4; ++j) {
#pragma unroll
                for (int st = 0; st < 2; ++st) {
                    u32x4 sp; sp.x = pk2(S[j][8 * st + 0], S[j][8 * st + 1]); sp.y = pk2(S[j][8 * st + 2], S[j][8 * st + 3]); sp.z = pk2(S[j][8 * st + 4], S[j][8 * st + 5]); sp.w = pk2(S[j][8 * st + 6], S[j][8 * st + 7]);
                    const bf16x8 sfrag = __builtin_bit_cast(bf16x8, sp);
                    const LAS unsigned char* qf = lds + QB_OFF + ((((4 * kh + j) * 2 + st) * 2) * 1024) + lane * 16;
                    op0 = MFMA32(*(const LAS bf16x8*)(qf), sfrag, op0);
                    op1 = MFMA32(*(const LAS bf16x8*)(qf + 1024), sfrag, op1);
                }
            }
            __syncthreads();
            if (c + 1 < 64) SC_DMA(c + 1);
            f32x16 o;
#pragma unroll
            for (int i = 0; i < 16; ++i) { XCH[w * 1024 + i * 64 + lane] = kh ? op0[i] : op1[i]; o[i] = kh ? op1[i] : op0[i]; }
            bf16x8 vf[4];
#pragma unroll
            for (int st = 0; st < 4; ++st) vf[st] = *(const LAS bf16x8*)(lds + VT2_OFF + ((32 * vb + r) * TSTR + 16 * st + 8 * h2) * 2);
            o = MFMA32(__builtin_bit_cast(bf16x8, pf[0]), vf[0], o);
            o = MFMA32(__builtin_bit_cast(bf16x8, pf[1]), vf[1], o);
            if (kh) { o = MFMA32(__builtin_bit_cast(bf16x8, pf[2]), vf[2], o); o = MFMA32(__builtin_bit_cast(bf16x8, pf[3]), vf[3], o); }
            if (c + 1 < 64) SC_LOADP(c + 1);
            const LAS unsigned char* kfb = lds + KB_OFF + (c & 1) * 32768 + lane * 16;
            const LAS float* EVc = (const LAS float*)(lds + EV2_OFF + (c & 1) * 1024);
#pragma unroll
            for (int j = 0; j < 4; ++j) {
                const int kb = 4 * kh + j;
#pragma unroll
                for (int st = 0; st < 4; ++st) S[j] = MFMA32(*(const LAS bf16x8*)(kfb + (kb * 4 + st) * 1024), vf[st], S[j]);
                if (MODE == 0) {
#pragma unroll
                    for (int g4 = 0; g4 < 4; ++g4) { const f32x4 e = *(const LAS f32x4*)(EVc + 32 * kb + 8 * g4 + 4 * h2);
#pragma unroll
                        for (int q = 0; q < 4; ++q) S[j][4 * g4 + q] *= e[q]; }
                } else {
#pragma unroll
                    for (int i = 0; i < 16; ++i) S[j][i] *= gdec;
                }
            }
            __syncthreads();
#pragma unroll
            for (int i = 0; i < 16; ++i) oprev[i] = o[i] + XCH[(w ^ 4) * 1024 + i * 64 + lane];
        }
        {
            char* op = (char*)(vbase + (size_t)(63 * 64 + 32 * kh) * LD);
            const unsigned olo = ((unsigned)(4 * h2) * LD + 32 * vb + r) * 2u;
#pragma unroll
            for (int i = 0; i < 16; ++i) __builtin_nontemporal_store((bf16_t)(pk2(oprev[i], 0.f) & 0xffffu), (bf16_t*)(op + (size_t)((i & 3) + 8 * (i >> 2)) * (LD * 2) + olo));
        }
#undef SC_SEG
#undef SC_DMA
#undef SC_LOADV
#undef SC_LOADP
        asm volatile("s_waitcnt vmcnt(0)" ::: "memory");
        __syncthreads();
    }
}

template <int MODE>
__device__ __forceinline__ void ew_phase(bf16_t* proj, const float* gain, const float* bias, int gw, int NGW, int lane) {
    constexpr int H = MODE ? 8 : 4, DV = MODE ? 512 : 1024, LD = MODE ? N1 : N0, NC = DV / 512;
    constexpr int VOFF = MODE ? 4096 : 2048, GOFF = VOFF + DI;
    for (int p = gw; p < T * H; p += NGW) {
        const int t = p / H, hh = p % H;
        bf16_t* orow = proj + (size_t)t * LD + VOFF + hh * DV;
        const bf16_t* grow = proj + (size_t)t * LD + GOFF + hh * DV;
        u32x4 ov[NC], gv[NC];
#pragma unroll
        for (int cc = 0; cc < NC; ++cc) { ov[cc] = __builtin_nontemporal_load((const u32x4*)(orow + cc * 512 + lane * 8)); gv[cc] = __builtin_nontemporal_load((const u32x4*)(grow + cc * 512 + lane * 8)); }
        float s1 = 0.f, s2 = 0.f;
#pragma unroll
        for (int cc = 0; cc < NC; ++cc)
#pragma unroll
            for (int q = 0; q < 4; ++q) { const float oa = bflo(ov[cc][q]), ob = bfhi(ov[cc][q]); s1 += oa + ob; s2 += oa * oa + ob * ob; }
        s1 = wave_sum(s1); s2 = wave_sum(s2);
        float mu = 0.f, rs;
        if (MODE == 0) rs = rsqrtf(s2 * (1.0f / DV) + EPS);
        else { mu = s1 * (1.0f / DV); rs = rsqrtf(fmaxf(s2 * (1.0f / DV) - mu * mu, 0.f) + EPS); }
#pragma unroll
        for (int cc = 0; cc < NC; ++cc) {
            const int col = cc * 512 + lane * 8;
            const f32x4 g0 = *(const f32x4*)(gain + hh * DV + col), g1 = *(const f32x4*)(gain + hh * DV + col + 4);
            f32x4 b0 = (f32x4){0.f, 0.f, 0.f, 0.f}, b1 = b0;
            if (MODE == 1) { b0 = *(const f32x4*)(bias + hh * DV + col); b1 = *(const f32x4*)(bias + hh * DV + col + 4); }
            const float gg[8] = {g0[0], g0[1], g0[2], g0[3], g1[0], g1[1], g1[2], g1[3]}, bb[8] = {b0[0], b0[1], b0[2], b0[3], b1[0], b1[1], b1[2], b1[3]};
            u32x4 res;
#pragma unroll
            for (int q = 0; q < 4; ++q) {
                const float oa = bflo(ov[cc][q]), ob = bfhi(ov[cc][q]), ga = bflo(gv[cc][q]), gb = bfhi(gv[cc][q]);
                const float ya = ((oa - mu) * rs * gg[2 * q] + bb[2 * q]) * (ga / (1.0f + __expf(-ga)));
                const float yb = ((ob - mu) * rs * gg[2 * q + 1] + bb[2 * q + 1]) * (gb / (1.0f + __expf(-gb)));
                res[q] = pk2(ya, yb);
            }
            *(u32x4*)(orow + col) = res;
        }
    }
}

__device__ __forceinline__ void p0_transpose_item(const float* W, int K, int N, bf16_t* WT, int row_off, LAS float* scr, int item, int lane, const float* kvec, int sc0, int sc1, float sc) {
    const int nblk = N / 32, kb = item / nblk, nb = item % nblk, k0 = 64 * kb, n0 = 32 * nb;
    const float cs = (n0 >= sc0 && n0 < sc1) ? sc : 1.0f;
#pragma unroll 8
    for (int i = 0; i < 32; ++i) { const int kk = 2 * i + (lane >> 5); const float kv = kvec ? kvec[k0 + kk] : 1.0f; scr[kk * 33 + (lane & 31)] = __builtin_nontemporal_load(W + (size_t)(k0 + kk) * N + n0 + (lane & 31)) * (kv * cs); }
    asm volatile("s_waitcnt lgkmcnt(0)" ::: "memory");
    const int c = lane & 7;
#pragma unroll
    for (int j = 0; j < 4; ++j) { const int n = (lane >> 3) + 8 * j; const LAS float* s = scr + (8 * c) * 33 + n;
        u32x4 o; o.x = pk2(s[0 * 33], s[1 * 33]); o.y = pk2(s[2 * 33], s[3 * 33]); o.z = pk2(s[4 * 33], s[5 * 33]); o.w = pk2(s[6 * 33], s[7 * 33]);
        *(u32x4*)(WT + (size_t)(row_off + n0 + n) * K + k0 + 8 * c) = o; }
    asm volatile("s_waitcnt lgkmcnt(0)" ::: "memory");
}

#define XB_TMO      128
#define XB_XCNT(j)  (256  + 64 * (j))
#define XB_XSUB(j)  (1280 + 64 * (j))
#define XB_XGEN(j)  (2304 + 64 * (j))
#define XB_TOP      3328
#define XB_TOPGEN   3392
#define XCD_BAR_WORDS 3456
#define XB_SPIN_CAP (1u << 18)

__device__ __forceinline__ unsigned xb_ld(unsigned* p)              { return __hip_atomic_load(p, __ATOMIC_RELAXED, __HIP_MEMORY_SCOPE_AGENT); }
__device__ __forceinline__ unsigned xb_add(unsigned* p, unsigned v) { return __hip_atomic_fetch_add(p, v, __ATOMIC_RELAXED, __HIP_MEMORY_SCOPE_AGENT); }
__device__ __forceinline__ unsigned xb_xcc_id() { return (unsigned)__builtin_amdgcn_s_getreg((3 << 11) | 20) & 0xFu; }
#define XB_SPIN(cond, bar) do { unsigned _sp = 0; while (cond) { __builtin_amdgcn_s_sleep(1); \
    if ((++_sp & 255u) == 0u) { if (xb_ld(&(bar)[XB_TMO])) break; if (_sp > XB_SPIN_CAP) { atomicAdd(&(bar)[XB_TMO], 1u); break; } } } } while (0)

struct XcdBarrier {
    unsigned* bar; unsigned x;
    volatile LAS unsigned* st;
};

__device__ __forceinline__ XcdBarrier xcd_barrier_post(unsigned* bar, volatile LAS unsigned* st) {
    XcdBarrier b; b.bar = bar; b.x = xb_xcc_id(); b.st = st;
    if (threadIdx.x == 0) st[2] = xb_add(&bar[XB_XCNT(b.x)], 1u);
    return b;
}
__device__ __forceinline__ void xcd_barrier_complete(unsigned* bar, unsigned x, unsigned& nloc, unsigned& nx) {
    const unsigned G = gridDim.x * gridDim.y * gridDim.z;
    unsigned sum, cnt, mine, sp = 0u;
    for (;;) {
        sum = 0u; cnt = 0u; mine = 0u;
#pragma unroll
        for (unsigned j = 0; j < 16; ++j) { const unsigned c = xb_ld(&bar[XB_XCNT(j)]); sum += c; cnt += (c > 0u) ? 1u : 0u; mine = (j == x) ? c : mine; }
        if (sum == G) break;
        __builtin_amdgcn_s_sleep(1);
        if ((++sp & 255u) == 0u) { if (xb_ld(&bar[XB_TMO])) break; if (sp > XB_SPIN_CAP) { atomicAdd(&bar[XB_TMO], 1u); break; } }
    }
    nloc = mine > 0u ? mine : 1u; nx = cnt > 0u ? cnt : 1u;
}

__device__ __forceinline__ void xcd_barrier(const XcdBarrier& b) {
    asm volatile("s_waitcnt vmcnt(0)" ::: "memory");
    __syncthreads();
    if (threadIdx.x == 0) {
        unsigned* bar = b.bar;
        __builtin_amdgcn_s_waitcnt(0);
        unsigned nloc = b.st[0], nx = b.st[1];
        if (nloc == 0u) { xcd_barrier_complete(bar, b.x, nloc, nx); b.st[0] = nloc; b.st[1] = nx; }
        const unsigned old = xb_add(&bar[XB_XSUB(b.x)], 1u);
        const unsigned gen = old / nloc;
        if (old + 1u == (gen + 1u) * nloc) {
            __builtin_amdgcn_fence(__ATOMIC_RELEASE, "agent");
            asm volatile("s_waitcnt vmcnt(0)" ::: "memory");
            const unsigned og = xb_add(&bar[XB_TOP], 1u);
            const unsigned tg = og / nx;
            if (og + 1u == (tg + 1u) * nx) xb_add(&bar[XB_TOPGEN], 1u);
            else XB_SPIN(xb_ld(&bar[XB_TOPGEN]) == tg, bar);
            __builtin_amdgcn_fence(__ATOMIC_ACQUIRE, "agent");
            xb_add(&bar[XB_XGEN(b.x)], 1u);
            asm volatile("s_waitcnt vmcnt(0)" ::: "memory");
        } else {
            XB_SPIN(xb_ld(&bar[XB_XGEN(b.x)]) == gen, bar);
            __builtin_amdgcn_fence(__ATOMIC_ACQUIRE, "agent");
            asm volatile("s_waitcnt vmcnt(0)" ::: "memory");
        }
    }
    __syncthreads();
}

struct Args {
    const float* x; const int* pos;
    const float *gla_norm, *gla_w_in, *gla_w_a1, *gla_w_a2, *gla_b_a, *gla_head_g, *gla_w_out;
    const float *ret_norm, *ret_w_in, *ret_gn_g, *ret_gn_b, *ret_w_out, *final_norm;
    float* out; unsigned char* ws;
};

__global__ void __launch_bounds__(512, 2) fwd(Args a) {
    extern __shared__ __attribute__((aligned(16))) unsigned char lds_raw[];
    LAS unsigned char* lds = (LAS unsigned char*)lds_raw;
    cg::grid_group grid = cg::this_grid();
    const int tid = threadIdx.x, lane = tid & 63, wave = __builtin_amdgcn_readfirstlane(tid >> 6);
    const int G = gridDim.x, bx = blockIdx.x;
    const int vcu = (G % 8 == 0) ? (bx % 8) * (G / 8) + bx / 8 : bx;
    const int gw = vcu * 8 + wave, NGW = G * 8;
    const int gtid = bx * 512 + tid, NGT = G * 512;
    unsigned char* ws = a.ws;
    if (tid < 4) ((LAS unsigned*)(lds + LDS_BARW))[tid] = 0u;
    __syncthreads();
    XcdBarrier xbar = xcd_barrier_post((unsigned*)(ws + WS_BAR), (volatile LAS unsigned*)(lds + LDS_BARW));
    bf16_t* W0T = (bf16_t*)(ws + WS_W0T); bf16_t* WOUT0T = (bf16_t*)(ws + WS_WOUT0T); bf16_t* W1T = (bf16_t*)(ws + WS_W1T); bf16_t* WOUT1T = (bf16_t*)(ws + WS_WOUT1T);
    bf16_t* H1BF = (bf16_t*)(ws + WS_H1BF); bf16_t* PROJ = (bf16_t*)(ws + WS_PROJ);
    bf16_t* HN = (bf16_t*)a.out;
    f32x2* ROT = (f32x2*)(ws + WS_ROT); float* SUMSQ1 = (float*)(ws + WS_SUMSQ1);

#ifdef PROBE_A
    unsigned long long* TS = (unsigned long long*)(ws + 60 * MiB);
    int nst = 0;
#define STAMP() do { if (bx == 0 && tid == 0) TS[nst] = __builtin_amdgcn_s_memrealtime(); ++nst; } while (0)
#else
#define STAMP() do {} while (0)
#endif
    STAMP();
    {
        LAS float* scr = (LAS float*)(lds + wave * 8704);
        constexpr int I_W0 = (D / 64) * (10240 / 32), I_WO = (DI / 64) * (D / 32), I_W1 = (D / 64) * (N1 / 32);
        constexpr int NITEMS = I_W0 + I_WO + I_W1 + I_WO;
        for (int it = gw; it < NITEMS; it += NGW) {
            int q = it;
            if (q < I_W0) { p0_transpose_item(a.gla_w_in, D, 10240, W0T, 0, scr, q, lane, nullptr, 0, 1024, 0.0625f); continue; } q -= I_W0;
            if (q < I_WO) { p0_transpose_item(a.gla_w_out, DI, D, WOUT0T, 0, scr, q, lane, nullptr, 0, 0, 1.0f); continue; } q -= I_WO;
            if (q < I_W1) { p0_transpose_item(a.ret_w_in, D, N1, W1T, 0, scr, q, lane, a.ret_norm, 2048, 4096, 0.0625f); continue; } q -= I_W1;
            p0_transpose_item(a.ret_w_out, DI, D, WOUT1T, 0, scr, q, lane, nullptr, 0, 0, 1.0f);
        }
        for (int idx = gtid; idx < 1024 * 256; idx += NGT) {
            const int n = idx >> 8, kc = idx & 255;
            float a2[16];
#pragma unroll
            for (int rr = 0; rr < 16; ++rr) a2[rr] = a.gla_w_a2[rr * 1024 + n];
            float res[8];
#pragma unroll
            for (int kk = 0; kk < 8; ++kk) {
                const f32x4* p = (const f32x4*)(a.gla_w_a1 + (size_t)(8 * kc + kk) * 16);
                const f32x4 p0 = p[0], p1 = p[1], p2 = p[2], p3 = p[3];
                res[kk] = p0[0] * a2[0] + p0[1] * a2[1] + p0[2] * a2[2] + p0[3] * a2[3] + p1[0] * a2[4] + p1[1] * a2[5] + p1[2] * a2[6] + p1[3] * a2[7]
                        + p2[0] * a2[8] + p2[1] * a2[9] + p2[2] * a2[10] + p2[3] * a2[11] + p3[0] * a2[12] + p3[1] * a2[13] + p3[2] * a2[14] + p3[3] * a2[15];
            }
            *(u32x4*)(W0T + (size_t)(10240 + n) * D + 8 * kc) = (u32x4){pk2(res[0], res[1]), pk2(res[2], res[3]), pk2(res[4], res[5]), pk2(res[6], res[7])};
        }
        for (int m = gw; m < T; m += NGW) {
            const f32x4* xr = (const f32x4*)(a.x + (size_t)m * D) + lane;
            const f32x4* gr = (const f32x4*)a.gla_norm + lane;
            f32x4 v[8]; float s = 0.f;
#pragma unroll
            for (int j = 0; j < 8; ++j) { v[j] = __builtin_nontemporal_load(xr + 64 * j); s += (v[j][0] * v[j][0] + v[j][1] * v[j][1]) + (v[j][2] * v[j][2] + v[j][3] * v[j][3]); }
            const float rs = rsqrtf(wave_sum(s) * (1.0f / D) + EPS);
            u32x2* o8 = (u32x2*)(HN + (size_t)m * D) + lane;
#pragma unroll
            for (int j = 0; j < 8; ++j) { const f32x4 g = gr[64 * j]; o8[64 * j] = (u32x2){pk2(v[j][0] * rs * g[0], v[j][1] * rs * g[1]), pk2(v[j][2] * rs * g[2], v[j][3] * rs * g[3])}; }
        }
    }
    if (a.ws == nullptr) grid.sync();
    xcd_barrier(xbar); STAMP();
    int pcu;
    {
        volatile LAS unsigned* bst = (volatile LAS unsigned*)(lds + LDS_BARW);
        if (tid == 0) {
            const unsigned* bw = (const unsigned*)(ws + WS_BAR);
            unsigned base = 0u;
            unsigned even = (G % 8 == 0) ? 1u : 0u;
            for (unsigned j = 0; j < 16; ++j) { const unsigned cj = __hip_atomic_load(bw + XB_XCNT(j), __ATOMIC_RELAXED, __HIP_MEMORY_SCOPE_AGENT); if (j < xbar.x) base += cj;
                if (cj != (j < 8 ? (unsigned)G / 8u : 0u)) even = 0u; }
            bst[3] = (base + bst[2]) | (even << 16);
        }
        __syncthreads();
        pcu = (int)(bst[3] & 0xffffu);
        if (pcu < 0 || pcu >= G) pcu = vcu;
    }
    const bool xcc_even = (((volatile LAS unsigned*)(lds + LDS_BARW))[3] >> 16) != 0u;
    const int gcu = xcc_even ? (pcu % (G / 8)) * 8 + (int)xbar.x : bx;
    {
        pg8::Gemm g{HN, W0T, T, N0, D, D}; pg8::StaticOrder S; S.init(T, N0, G, gcu);
        pg8::EpiProj E{PROJ, N0, 0, nullptr, a.gla_b_a, nullptr};
        pg8::gemm_phase<pg8::EpiProj>(lds, g, S, E);
    }
    xcd_barrier(xbar); STAMP();
    prescan_phase<0>(lds, PROJ, nullptr, pcu, G);
    xcd_barrier(xbar); STAMP();
    scan_phase<0>(lds, PROJ, nullptr, pcu, G);
    xcd_barrier(xbar); STAMP();
    {
        ew_phase<0>(PROJ, a.gla_head_g, nullptr, gw, NGW, lane);
        for (int idx = gtid; idx < T * 128; idx += NGT) {
            const int t = idx >> 7, i = idx & 127;
            const double invf = exp(-(double)i * (9.210340371976184 / 128.0));
            const double ang = (double)a.pos[t] * invf;
            double rev = ang * 0.15915494309189535; rev -= floor(rev);
            const float fr = (float)rev;
            ROT[idx] = (f32x2){__builtin_amdgcn_cosf(fr), __builtin_amdgcn_sinf(fr)};
        }
        for (int idx = gtid; idx < T; idx += NGT) SUMSQ1[idx] = 0.f;
    }
    xcd_barrier(xbar); STAMP();
    {
        pg8::Gemm g{PROJ + 2048, WOUT0T, T, D, DI, N0}; pg8::StaticOrder S; S.init(T, D, G, gcu);
        pg8::EpiOut E{a.x, nullptr, H1BF, SUMSQ1};
        pg8::gemm_phase<pg8::EpiOut>(lds, g, S, E);
    }
    xcd_barrier(xbar); STAMP();
    {
        pg8::Gemm g{H1BF, W1T, T, N1, D, D}; pg8::StaticOrder S; S.init(T, N1, G, gcu);
        pg8::EpiProj E{PROJ, N1, 1, SUMSQ1, nullptr, ROT};
        pg8::gemm_phase<pg8::EpiProj>(lds, g, S, E);
    }
    xcd_barrier(xbar); STAMP();
    prescan_phase<1>(lds, PROJ, ws + WS_ROT, pcu, G);
    xcd_barrier(xbar); STAMP();
    scan_phase<1>(lds, PROJ, ws + WS_ROT, pcu, G);
    xcd_barrier(xbar); STAMP();
    ew_phase<1>(PROJ, a.ret_gn_g, a.ret_gn_b, gw, NGW, lane);
    xcd_barrier(xbar); STAMP();
    {
        pg8::Gemm g{PROJ + 4096, WOUT1T, T, D, DI, N1}; pg8::StaticOrder S; S.init(T, D, G, gcu);
        pg8::EpiOut E{nullptr, H1BF, H1BF, nullptr};
        pg8::gemm_phase<pg8::EpiOut>(lds, g, S, E);
    }
    xcd_barrier(xbar); STAMP();
    for (int m = gw; m < T; m += NGW) {
        const u32x4* hr = (const u32x4*)(H1BF + (size_t)m * D) + lane;
        u32x4 hv[4]; float s = 0.f;
#pragma unroll
        for (int j = 0; j < 4; ++j) { hv[j] = __builtin_nontemporal_load(hr + 64 * j);
#pragma unroll
            for (int q = 0; q < 4; ++q) { const float lo = bflo(hv[j][q]), hi = bfhi(hv[j][q]); s += lo * lo + hi * hi; } }
        const float rs = rsqrtf(wave_sum(s) * (1.0f / D) + EPS);
#pragma unroll
        for (int j = 0; j < 4; ++j) {
            const int col = 512 * j + 8 * lane;
            const f32x4 g0 = *(const f32x4*)(a.final_norm + col), g1 = *(const f32x4*)(a.final_norm + col + 4);
            f32x4 y0 = (f32x4){bflo(hv[j][0]), bfhi(hv[j][0]), bflo(hv[j][1]), bfhi(hv[j][1])} * rs * g0;
            f32x4 y1 = (f32x4){bflo(hv[j][2]), bfhi(hv[j][2]), bflo(hv[j][3]), bfhi(hv[j][3])} * rs * g1;
            __builtin_nontemporal_store(y0, (f32x4*)(a.out + (size_t)m * D + col)); __builtin_nontemporal_store(y1, (f32x4*)(a.out + (size_t)m * D + col + 4));
        }
    }
}

extern "C" void kernel_launch(void* const* d_in, const int* in_sizes, int n_in, void* d_out, int out_size, void* d_ws, size_t ws_size, hipStream_t stream) {
    static int grid = 0;
    if (grid == 0) {
        int dev = 0, cus = 0, per_cu = 0;
        (void)hipGetDevice(&dev);
        (void)hipDeviceGetAttribute(&cus, hipDeviceAttributeMultiprocessorCount, dev);
        (void)hipFuncSetAttribute((const void*)fwd, hipFuncAttributeMaxDynamicSharedMemorySize, LDS_BYTES);
        (void)hipOccupancyMaxActiveBlocksPerMultiprocessor(&per_cu, (const void*)fwd, 512, LDS_BYTES);
        if (per_cu < 1) per_cu = 1;
        grid = cus * per_cu;
        if (ws_size < 1024 * MiB) fprintf(stderr, "kernel_launch: workspace too small (%zu)\n", ws_size);
    }
    Args a{};
    a.x = (const float*)d_in[0]; a.pos = (const int*)d_in[1];
    a.gla_norm = (const float*)d_in[2]; a.gla_w_in = (const float*)d_in[3]; a.gla_w_a1 = (const float*)d_in[4]; a.gla_w_a2 = (const float*)d_in[5];
    a.gla_b_a = (const float*)d_in[6]; a.gla_head_g = (const float*)d_in[7]; a.gla_w_out = (const float*)d_in[8];
    a.ret_norm = (const float*)d_in[9]; a.ret_w_in = (const float*)d_in[10]; a.ret_gn_g = (const float*)d_in[11]; a.ret_gn_b = (const float*)d_in[12];
    a.ret_w_out = (const float*)d_in[13]; a.final_norm = (const float*)d_in[14];
    a.out = (float*)d_out; a.ws = (unsigned char*)d_ws;
    (void)hipMemsetAsync((char*)d_ws + WS_BAR, 0, WS_BAR_BYTES, stream);
    void* args[] = {&a};
    hipError_t e = hipLaunchCooperativeKernel((const void*)fwd, dim3(grid), dim3(512), args, LDS_BYTES, stream);
    if (e != hipSuccess) fprintf(stderr, "cooperative launch failed: %s (grid %d)\n", hipGetErrorString(e), grid);
}
```

```cpp
#include <hip/hip_runtime.h>
#include <hip/hip_cooperative_groups.h>
#include <cstdio>
#include <cstdint>
namespace cg = cooperative_groups;

#define LAS __attribute__((address_space(3)))
typedef unsigned short bf16_t;
typedef short bf16x8 __attribute__((ext_vector_type(8)));
typedef short s16x4 __attribute__((ext_vector_type(4)));
typedef float f32x4 __attribute__((ext_vector_type(4)));
typedef float f32x2 __attribute__((ext_vector_type(2)));
typedef float f32x16 __attribute__((ext_vector_type(16)));
typedef unsigned u32x4 __attribute__((ext_vector_type(4)));
typedef unsigned u32x2 __attribute__((ext_vector_type(2)));
typedef __bf16 bf2_t __attribute__((ext_vector_type(2)));

constexpr int T = 32768, D = 2048, DI = 4096, SEQ = 4096;
constexpr int N0 = 11264, N1 = 12288;
constexpr float EPS = 1e-6f;
constexpr size_t MiB = 1u << 20;
constexpr size_t WS_W0T = 0, WS_WOUT0T = 44 * MiB, WS_W1T = 64 * MiB, WS_WOUT1T = 112 * MiB, WS_H1BF = 128 * MiB, WS_PROJ = 256 * MiB;
constexpr size_t WS_ROT = 0, WS_SUMSQ1 = 32 * MiB;
constexpr int LDS_BYTES = 155648, LDS_BARW = 155584;
constexpr size_t WS_BAR = 60 * MiB, WS_BAR_BYTES = 16384;

__device__ __forceinline__ unsigned pk2(float lo, float hi) { bf2_t r = __builtin_convertvector((f32x2){lo, hi}, bf2_t); return __builtin_bit_cast(unsigned, r); }
__device__ __forceinline__ float bflo(unsigned u) { return __builtin_bit_cast(float, u << 16); }
__device__ __forceinline__ float bfhi(unsigned u) { return __builtin_bit_cast(float, u & 0xffff0000u); }
__device__ __forceinline__ float wave_sum(float v) {
#pragma unroll
    for (int o = 1; o < 64; o <<= 1) v += __shfl_xor(v, o);
    return v;
}

namespace pg8 {
constexpr int BM = 256, BK = 64, HALF = 128, HTB = HALF * BK * 2, STAGE_BYTES = 8 * HTB, NXCD = 8, WGM = 8;
__host__ __device__ __forceinline__ int lds_byte(int r, int c) { const int st = (r >> 4) * 2 + (c >> 5), rr = r & 15, cc = c & 31, ob = rr * 64 + cc * 2; return st * 1024 + (ob ^ (((ob >> 9) & 1) << 5)); }
__host__ __device__ __forceinline__ void stage_rc(int b, int& R, int& C) { const int st = b / 1024, sb = b % 1024, swz = sb ^ (((sb >> 9) & 1) << 5); R = (st >> 1) * 16 + swz / 64; C = (st & 1) * 32 + (swz % 64) / 2; }
__host__ __device__ __forceinline__ int perm32(int rho) { const int n = rho >> 4, i = rho & 15; return 8 * (i >> 2) + 4 * n + (i & 3); }

struct Unit { int pm, pn; };
struct Gemm { const bf16_t* A; const bf16_t* Bt; int M, N, K, lda; };

struct StaticOrder {
    int nM, nN, nwg, G, c;
    __device__ void init(int M, int N, int G_, int c_) { nM = M / BM; nN = N / BM; nwg = nM * nN; G = G_; c = c_; }
    __device__ bool next(int i, Unit& u) const {
        const long L = (long)i * G + c; if (L >= nwg) return false;
        int wgid = (int)L; { const int q = nwg / NXCD, r = nwg % NXCD, xcd = wgid % NXCD, off = wgid / NXCD; wgid = (xcd < r ? xcd * (q + 1) : r * (q + 1) + (xcd - r) * q) + off; }
        const int nig = WGM * nN, gid = wgid / nig, fm = gid * WGM, gsz = (nM - fm) < WGM ? (nM - fm) : WGM;
        u.pm = fm + ((wgid % nig) % gsz); u.pn = (wgid % nig) / gsz; return true;
    }
};


struct EpiProj {
    static constexpr bool PERM = true;
    bf16_t* O; int ldc; int mode;
    const float* rowsumsq;
    const float* b_a;
    const f32x2* rot;
    __device__ __forceinline__ void operator()(const f32x4 (&acc)[2][2][4][2], const Unit& u, int wr, int wc, int fr, int fq) const {
        const int row0 = u.pm * BM + wr * 64 + fr, col0 = u.pn * BM + wc * 32 + 8 * fq;
        const bool is_a = (mode == 0) && (u.pn >= 40);
        const bool is_rot = (mode == 1) && (u.pn < 16);
        f32x4 bv[2][2];
#pragma unroll
        for (int bj = 0; bj < 2; ++bj)
#pragma unroll
            for (int n = 0; n < 2; ++n) bv[bj][n] = is_a ? *(const f32x4*)(b_a + (col0 - 10240) + bj * HALF + 4 * n) : (f32x4){0.f, 0.f, 0.f, 0.f};
#pragma unroll
        for (int ai = 0; ai < 2; ++ai)
#pragma unroll
            for (int m = 0; m < 4; ++m) {
                const int row = row0 + ai * HALF + m * 16;
                const float rs = rowsumsq ? rsqrtf(rowsumsq[row] * (1.0f / D) + EPS) : 1.0f;
                f32x4 v[2][2];
#pragma unroll
                for (int bj = 0; bj < 2; ++bj)
#pragma unroll
                    for (int n = 0; n < 2; ++n) v[bj][n] = acc[ai][bj][m][n] * rs;
                if (is_a) {
#pragma unroll
                    for (int bj = 0; bj < 2; ++bj)
#pragma unroll
                        for (int n = 0; n < 2; ++n)
#pragma unroll
                            for (int j = 0; j < 4; ++j) { const float x = v[bj][n][j] + bv[bj][n][j]; v[bj][n][j] = (fminf(x, 0.f) - __logf(1.0f + __expf(-fabsf(x)))) * (1.0f / 16.0f); }
                }
                if (is_rot) {
                    const f32x2* rp = rot + (size_t)row * 128 + wc * 32 + 8 * fq;
#pragma unroll
                    for (int n = 0; n < 2; ++n) {
                        const f32x4 t0 = *(const f32x4*)(rp + 4 * n), t1 = *(const f32x4*)(rp + 4 * n + 2);
                        const float cs[4] = {t0[0], t0[2], t1[0], t1[2]}, sn[4] = {t0[1], t0[3], t1[1], t1[3]};
#pragma unroll
                        for (int j = 0; j < 4; ++j) { const float x1 = v[0][n][j], x2 = v[1][n][j]; v[0][n][j] = x1 * cs[j] - x2 * sn[j]; v[1][n][j] = x2 * cs[j] + x1 * sn[j]; }
                    }
                }
                bf16_t* rowp = O + (size_t)row * ldc + col0;
#pragma unroll
                for (int bj = 0; bj < 2; ++bj) {
                    u32x4 w; w.x = pk2(v[bj][0][0], v[bj][0][1]); w.y = pk2(v[bj][0][2], v[bj][0][3]); w.z = pk2(v[bj][1][0], v[bj][1][1]); w.w = pk2(v[bj][1][2], v[bj][1][3]);
                    *(u32x4*)(rowp + bj * HALF) = w;
                }
            }
    }
};
struct EpiOut {
    static constexpr bool PERM = true;
    const float* resid32; const bf16_t* resid16; bf16_t* out16; float* sumsq;
    __device__ __forceinline__ void operator()(const f32x4 (&acc)[2][2][4][2], const Unit& u, int wr, int wc, int fr, int fq) const {
        const int row0 = u.pm * BM + wr * 64 + fr, col0 = u.pn * BM + wc * 32 + 8 * fq;
#pragma unroll
        for (int ai = 0; ai < 2; ++ai)
#pragma unroll
            for (int m = 0; m < 4; ++m) {
                const int row = row0 + ai * HALF + m * 16;
                const size_t off = (size_t)row * D + col0;
                float ss = 0.f;
#pragma unroll
                for (int bj = 0; bj < 2; ++bj) {
                    f32x4 r0, r1;
                    if (resid32) { r0 = __builtin_nontemporal_load((const f32x4*)(resid32 + off + bj * HALF)); r1 = __builtin_nontemporal_load((const f32x4*)(resid32 + off + bj * HALF + 4)); }
                    else { const u32x4 rr = *(const u32x4*)(resid16 + off + bj * HALF);
                           r0 = (f32x4){bflo(rr.x), bfhi(rr.x), bflo(rr.y), bfhi(rr.y)}; r1 = (f32x4){bflo(rr.z), bfhi(rr.z), bflo(rr.w), bfhi(rr.w)}; }
                    const f32x4 v0 = acc[ai][bj][m][0] + r0, v1 = acc[ai][bj][m][1] + r1;
                    ss += ((v0[0] * v0[0] + v0[1] * v0[1]) + (v0[2] * v0[2] + v0[3] * v0[3])) + ((v1[0] * v1[0] + v1[1] * v1[1]) + (v1[2] * v1[2] + v1[3] * v1[3]));
                    u32x4 w; w.x = pk2(v0[0], v0[1]); w.y = pk2(v0[2], v0[3]); w.z = pk2(v1[0], v1[1]); w.w = pk2(v1[2], v1[3]);
                    *(u32x4*)(out16 + off + bj * HALF) = w;
                }
                if (sumsq) { ss += __shfl_xor(ss, 16); ss += __shfl_xor(ss, 32); if (fq == 0) atomicAdd(sumsq + row, ss); }
            }
    }
};

template <class Epi>
__device__ __forceinline__ void gemm_phase(LAS unsigned char* lds, const Gemm g, const StaticOrder& S, const Epi& E) {
    const int tid = threadIdx.x, wid = __builtin_amdgcn_readfirstlane(tid >> 6), lane = tid & 63, wr = wid >> 2, wc = wid & 3, fr = lane & 15, fq = lane >> 4;
    const int K = g.K, nt = K / BK, lda = g.lda;
    unsigned voffA[2], voffB[2];
#pragma unroll
    for (int i = 0; i < 2; ++i) { int R, C; stage_rc(tid * 16 + i * 8192, R, C); const int Rb = Epi::PERM ? ((R & ~31) + perm32(R & 31)) : R;
        voffA[i] = (unsigned)(R * lda + C) * 2u; voffB[i] = (unsigned)(Rb * K + C) * 2u; }
    const size_t kstep = (size_t)(BK * 2);
    const size_t hstepA = (size_t)HALF * lda * 2, hstepB = (size_t)HALF * K * 2;
    const size_t tstepA = 2 * hstepA, tstepB = 2 * hstepB;
    const unsigned ldsw = (unsigned)wid * 1024u;
    const int aoff = lds_byte(wr * 64 + fr, fq * 8), boff = lds_byte(wc * 32 + fr, fq * 8);
#define PG8_SA(b, h) (((b) * 2 + (h)) * HTB)
#define PG8_SB(b, h) ((4 + (b) * 2 + (h)) * HTB)
#define PG8_STAGE(bufoff, gbase, voff) do { _Pragma("unroll") for (int _i = 0; _i < 2; ++_i) \
        __builtin_amdgcn_global_load_lds((const unsigned*)((const char*)(gbase) + (voff)[_i]), (LAS unsigned*)(lds + (bufoff) + ldsw + _i * 8192), 16, 0, 0); } while (0)
#define PG8_LDA(dst, b, h) do { _Pragma("unroll") for (int m = 0; m < 4; ++m) _Pragma("unroll") for (int k = 0; k < 2; ++k) dst[m][k] = *(const LAS bf16x8*)(lds + PG8_SA(b, h) + aoff + m * 2048 + k * 1024); } while (0)
#define PG8_LDB(dst, b, h) do { _Pragma("unroll") for (int n = 0; n < 2; ++n) _Pragma("unroll") for (int k = 0; k < 2; ++k) dst[n][k] = *(const LAS bf16x8*)(lds + PG8_SB(b, h) + boff + n * 2048 + k * 1024); } while (0)
#define PG8_MMA(ai, bj, At, Bt) do { __builtin_amdgcn_s_setprio(1); _Pragma("unroll") for (int m = 0; m < 4; ++m) _Pragma("unroll") for (int n = 0; n < 2; ++n) _Pragma("unroll") for (int k = 0; k < 2; ++k) \
        acc[ai][bj][m][n] = __builtin_amdgcn_mfma_f32_16x16x32_bf16(Bt[n][k], At[m][k], acc[ai][bj][m][n], 0, 0, 0); __builtin_amdgcn_s_setprio(0); } while (0)
#define PG8_WAIT_V(n) asm volatile("s_waitcnt vmcnt(" #n ")" ::: "memory")
#define PG8_WAIT_L(n) asm volatile("s_waitcnt lgkmcnt(" #n ")" ::: "memory")
#define PG8_BAR __builtin_amdgcn_s_barrier()
#define PG8_SCHED __builtin_amdgcn_sched_barrier(0)
    Unit cur, nxt; int ui = 0;
    if (!S.next(0, cur)) return;
    f32x4 acc[2][2][4][2];
#pragma unroll
    for (int a = 0; a < 2; ++a)
#pragma unroll
        for (int b = 0; b < 2; ++b)
#pragma unroll
            for (int m = 0; m < 4; ++m)
#pragma unroll
                for (int n = 0; n < 2; ++n) acc[a][b][m][n] = (f32x4){0.f, 0.f, 0.f, 0.f};
    bf16x8 At[4][2], B0[2][2], B1[2][2];
    const char* cA = (const char*)g.A + (size_t)cur.pm * tstepA; const char* cB = (const char*)g.Bt + (size_t)cur.pn * tstepB;
    PG8_STAGE(PG8_SB(0, 0), cB, voffB); PG8_STAGE(PG8_SB(0, 1), cB + hstepB, voffB); PG8_STAGE(PG8_SA(0, 0), cA, voffA); PG8_STAGE(PG8_SA(0, 1), cA + hstepA, voffA);
    if (wr == 1) PG8_BAR;
    PG8_WAIT_V(2); PG8_BAR;
    PG8_STAGE(PG8_SB(1, 0), cB + kstep, voffB); PG8_STAGE(PG8_SA(1, 0), cA + kstep, voffA); PG8_STAGE(PG8_SB(1, 1), cB + hstepB + kstep, voffB);
    PG8_WAIT_V(6); PG8_BAR;
    for (;;) {
        const bool has_next = S.next(ui + 1, nxt);
        const char* nA = has_next ? (const char*)g.A + (size_t)nxt.pm * tstepA : cA; const char* nB = has_next ? (const char*)g.Bt + (size_t)nxt.pn * tstepB : cB;
        for (int t = 0; t < nt; t += 2) {
            const bool last = (t == nt - 2);
            const char* a1 = cA + (size_t)(t + 1) * kstep;
            const char* a2 = last ? nA : cA + (size_t)(t + 2) * kstep; const char* b2 = last ? nB : cB + (size_t)(t + 2) * kstep;
            const char* a3 = a2 + kstep; const char* b3 = b2 + kstep;
            PG8_LDB(B0, 0, 0); PG8_LDB(B1, 0, 1); PG8_SCHED; PG8_LDA(At, 0, 0); PG8_STAGE(PG8_SA(1, 1), a1 + hstepA, voffA);
            PG8_WAIT_V(8); PG8_WAIT_L(0); PG8_BAR; PG8_MMA(0, 0, At, B0); PG8_MMA(0, 1, At, B1); PG8_BAR; PG8_SCHED;
            PG8_LDA(At, 0, 1); PG8_STAGE(PG8_SB(0, 0), b2, voffB); PG8_STAGE(PG8_SB(0, 1), b2 + hstepB, voffB); PG8_STAGE(PG8_SA(0, 0), a2, voffA);
            PG8_WAIT_V(8); PG8_WAIT_L(0); PG8_BAR; PG8_MMA(1, 0, At, B0); PG8_MMA(1, 1, At, B1); PG8_BAR; PG8_SCHED;
            PG8_LDB(B0, 1, 0); PG8_LDB(B1, 1, 1); PG8_SCHED; PG8_LDA(At, 1, 0); PG8_STAGE(PG8_SA(0, 1), a2 + hstepA, voffA);
            PG8_WAIT_V(8); PG8_WAIT_L(0); PG8_BAR; PG8_MMA(0, 0, At, B0); PG8_MMA(0, 1, At, B1); PG8_BAR; PG8_SCHED;
            PG8_LDA(At, 1, 1); PG8_STAGE(PG8_SB(1, 0), b3, voffB); PG8_STAGE(PG8_SB(1, 1), b3 + hstepB, voffB); PG8_STAGE(PG8_SA(1, 0), a3, voffA);
            PG8_WAIT_V(8); PG8_WAIT_L(0); PG8_BAR; PG8_MMA(1, 0, At, B0); PG8_MMA(1, 1, At, B1); PG8_BAR; PG8_SCHED;
        }
        if (wr == 0) PG8_BAR;
        E(acc, cur, wr, wc, fr, fq);
        if (!has_next) break;
#pragma unroll
        for (int a = 0; a < 2; ++a)
#pragma unroll
            for (int b = 0; b < 2; ++b)
#pragma unroll
                for (int m = 0; m < 4; ++m)
#pragma unroll
                    for (int n = 0; n < 2; ++n) acc[a][b][m][n] = (f32x4){0.f, 0.f, 0.f, 0.f};
        cur = nxt; cA = nA; cB = nB; ++ui;
        if (wr == 1) PG8_BAR;
    }
    PG8_WAIT_V(0);
    PG8_BAR;
#undef PG8_SA
#undef PG8_SB
#undef PG8_STAGE
#undef PG8_LDA
#undef PG8_LDB
#undef PG8_MMA
#undef PG8_WAIT_V
#undef PG8_WAIT_L
#undef PG8_BAR
#undef PG8_SCHED
}
}

constexpr int QT_OFF = 0, KH_OFF = 33792, KT_OFF = 67584, VT_OFF = 104448, PB_OFF = 122880, EV_OFF = 132096, TOT_OFF = 133120;
constexpr int QSTR = 264, TSTR = 72;
#define MFMA32(a, b, c) __builtin_amdgcn_mfma_f32_32x32x16_bf16((a), (b), (c), 0, 0, 0)
__device__ __forceinline__ int crow(int i, int h) { return (i & 3) + 8 * (i >> 2) + 4 * h; }

template <int MODE>
__device__ __forceinline__ void prescan_phase(LAS unsigned char* lds, bf16_t* proj, unsigned char* pf_ext, int vcu, int G) {
    constexpr int H = MODE ? 8 : 4, LD = MODE ? N1 : N0, KOFF = MODE ? 2048 : 1024, AOFF = 10240, NIT = 8 * H * 64;
    const int tid = threadIdx.x, lane = tid & 63, w = __builtin_amdgcn_readfirstlane(tid >> 6);
    const int r = lane & 31, h2 = lane >> 5;
    const int cp = tid & 127, sq = w >> 1;
    LAS float* EV = (LAS float*)(lds + EV_OFF);
    LAS float* TOT = (LAS float*)(lds + TOT_OFF);
    const unsigned qlo = ((unsigned)(16 * sq) * LD + 2 * cp) * 2u;
    const unsigned flo = (unsigned)h2 * (LD * 2) + r * 16;
    unsigned rq[16], rk[16], ra[16];
#define PRE_BASE(it) (proj + ((size_t)((it) / (64 * H)) * SEQ + (size_t)((it) % 64) * 64) * LD + (((it) / 64) % H) * 256)
#define PRE_LOAD(it) do { const char* _p = (const char*)PRE_BASE(it); \
        _Pragma("unroll") for (int i = 0; i < 16; ++i) { const char* _pi = _p + (size_t)i * (LD * 2); \
            rq[i] = __builtin_nontemporal_load((const unsigned*)(_pi + qlo)); rk[i] = __builtin_nontemporal_load((const unsigned*)(_pi + KOFF * 2 + qlo)); \
            if (MODE == 0) ra[i] = __builtin_nontemporal_load((const unsigned*)(_pi + AOFF * 2 + qlo)); } } while (0)
    const bool colo = (G == 256);
    const int nit_blk = colo ? NIT / 256 : (NIT - vcu + G - 1) / G;
#define PRE_ITEM(k) (colo ? (((vcu >> 5) * (NIT / 512) + (((vcu & 31) + 32 * (k)) >> 6)) * 64 + (((vcu & 31) + 32 * (k)) & 63)) : (vcu + (k) * G))
    if (nit_blk > 0) PRE_LOAD(PRE_ITEM(0));
    for (int kk = 0; kk < nit_blk; ++kk) {
        const int item = PRE_ITEM(kk);
        const int hh = (item / 64) % H;
        char* qseg = (char*)PRE_BASE(item);
        const float lg = MODE ? log1pf(-exp2f(-5.0f - (float)hh)) : 0.f;
        float run0 = 0.f, run1 = 0.f;
        if (MODE == 0) {
            float a0 = 0.f, a1 = 0.f;
#pragma unroll
            for (int i = 0; i < 16; ++i) { a0 += bflo(ra[i]); a1 += bfhi(ra[i]); }
            *(LAS f32x2*)(TOT + sq * 256 + 2 * cp) = (f32x2){a0, a1};
        }
        __syncthreads();
        float lgc = lg;
        if (MODE == 0) {
#pragma unroll
            for (int q = 0; q < 3; ++q) if (q < sq) { const f32x2 t = *(LAS f32x2*)(TOT + q * 256 + 2 * cp); run0 += t[0]; run1 += t[1]; }
        } else {
            asm volatile("" : "+v"(lgc));
        }
#pragma unroll
        for (int hf = 0; hf < 2; ++hf) {
            unsigned kt0[4], kt1[4];
#pragma unroll
            for (int ii = 0; ii < 8; ii += 2) {
                float ka[2], kb2[2];
#pragma unroll
                for (int d = 0; d < 2; ++d) {
                    const int i = 8 * hf + ii + d, s = 16 * sq + i;
                    float cu0, cu1;
                    if (MODE == 0) { run0 += bflo(ra[i]); run1 += bfhi(ra[i]); cu0 = run0; cu1 = run1; }
                    else { cu0 = lgc * (float)(s + 1); cu1 = cu0; }
                    const float e0 = __expf(cu0), e1 = __expf(cu1), f0 = __expf(-cu0), f1 = __expf(-cu1);
                    *(LAS unsigned*)(lds + QT_OFF + (s * QSTR + 2 * cp) * 2) = pk2(bflo(rq[i]) * e0, bfhi(rq[i]) * e1);
                    ka[d] = bflo(rk[i]) * f0; kb2[d] = bfhi(rk[i]) * f1;
                    *(LAS unsigned*)(lds + KH_OFF + (s * QSTR + 2 * cp) * 2) = pk2(ka[d], kb2[d]);
                    if (MODE == 0 && i == 15 && sq == 3) *(LAS f32x2*)(EV + 2 * cp) = (f32x2){e0, e1};
                }
                kt0[ii >> 1] = pk2(ka[0], ka[1]); kt1[ii >> 1] = pk2(kb2[0], kb2[1]);
            }
            LAS unsigned char* kt = lds + KT_OFF + ((2 * cp) * TSTR + 16 * sq + 8 * hf) * 2;
            *(LAS u32x4*)(kt) = (u32x4){kt0[0], kt0[1], kt0[2], kt0[3]};
            *(LAS u32x4*)(kt + TSTR * 2) = (u32x4){kt1[0], kt1[1], kt1[2], kt1[3]};
        }
        __syncthreads();
        if (kk + 1 < nit_blk) PRE_LOAD(PRE_ITEM(kk + 1));
        if (w < 3) {
            const int tb = (w >= 1) ? 1 : 0, sb = (w == 2) ? 1 : 0;
            f32x16 P;
#pragma unroll
            for (int i = 0; i < 16; ++i) P[i] = 0.f;
            const LAS unsigned char* qa = lds + QT_OFF + ((32 * tb + r) * QSTR + 8 * h2) * 2;
            const LAS unsigned char* kb_ = lds + KH_OFF + ((32 * sb + r) * QSTR + 8 * h2) * 2;
#pragma unroll
            for (int st = 0; st < 16; ++st) P = MFMA32(*(const LAS bf16x8*)(qa + st * 32), *(const LAS bf16x8*)(kb_ + st * 32), P);
            LAS bf16_t* pb = (LAS bf16_t*)(lds + PB_OFF);
#pragma unroll
            for (int i = 0; i < 16; ++i) {
                const int tr = crow(i, h2);
                const float pv = (tb == sb && r > tr) ? 0.f : P[i];
                pb[(32 * tb + tr) * TSTR + 32 * sb + r] = (bf16_t)(pk2(pv, 0.f) & 0xffffu);
            }
        }
#pragma unroll
        for (int i = 0; i < 4; ++i) {
            const int f = 4 * w + i, tb = f & 1, st = (f >> 1) & 1, kb = f >> 2;
            const LAS unsigned char* q0 = lds + QT_OFF + ((32 * tb + r) * QSTR + 32 * kb + 16 * st + 4 * h2) * 2;
            const u32x2 lo = *(const LAS u32x2*)(q0), hi = *(const LAS u32x2*)(q0 + 16);
            *(u32x4*)(qseg + (size_t)(2 * f) * (LD * 2) + flo) = (u32x4){lo.x, lo.y, hi.x, hi.y};
        }
#pragma unroll
        for (int i = 0; i < 4; ++i) {
            const int f = 4 * w + i, st = i, kb = w;
            const u32x4 kv = *(const LAS u32x4*)(lds + KT_OFF + ((32 * kb + r) * TSTR + 16 * st + 8 * h2) * 2);
            *(u32x4*)(qseg + KOFF * 2 + (size_t)(2 * f) * (LD * 2) + flo) = kv;
        }
        __syncthreads();
        if (w != 2 && w != 3) {
            const int tb = w >> 2, st = w & 3;
            const u32x4 pv = *(const LAS u32x4*)(lds + PB_OFF + ((32 * tb + r) * TSTR + 16 * st + 8 * h2) * 2);
            if (MODE == 0) *(u32x4*)(qseg + AOFF * 2 + (size_t)(2 * w) * (LD * 2) + flo) = pv;
            else *(u32x4*)(pf_ext + (size_t)item * 8192 + w * 1024 + lane * 16) = pv;
        } else if (MODE == 0 && w == 2) {
            const f32x4 ev = *(const LAS f32x4*)(EV + 4 * lane);
            *(f32x4*)(qseg + AOFF * 2 + (size_t)16 * (LD * 2) + flo) = ev;
        }
    }
#undef PRE_LOAD
#undef PRE_BASE
#undef PRE_ITEM
    __syncthreads();
}

constexpr int QB_OFF = 0, KB_OFF = 32768, VT2_OFF = 98304, EV2_OFF = 116736, XCH_OFF = 118784;
template <int MODE>
__device__ __forceinline__ void scan_phase(LAS unsigned char* lds, bf16_t* proj, const unsigned char* pf_ext, int vcu, int G) {
    constexpr int H = MODE ? 8 : 4, DV = MODE ? 512 : 1024, NSL = DV / 128, LD = MODE ? N1 : N0;
    constexpr int KOFF = MODE ? 2048 : 1024, VOFF = MODE ? 4096 : 2048, AOFF = 10240;
    const int tid = threadIdx.x, lane = tid & 63, w = __builtin_amdgcn_readfirstlane(tid >> 6);
    const int r = lane & 31, h2 = lane >> 5, vb = w & 3, kh = w >> 2;
    const int vp = lane, s8 = w;
    LAS float* XCH = (LAS float*)(lds + XCH_OFF);
    const unsigned flo = (unsigned)h2 * (LD * 2) + r * 16;
    const unsigned vlo = ((unsigned)(8 * s8) * LD + 2 * vp) * 2u;
    for (int item = vcu; item < 256; item += G) {
        const int vs = item % NSL, hh = (item / NSL) % H, b = item / (NSL * H);
        const size_t rowb = (size_t)b * SEQ;
        const char* qseg0 = (const char*)(proj + rowb * LD + hh * 256);
        bf16_t* vbase = proj + rowb * LD + VOFF + hh * DV + vs * 128;
        const unsigned char* pfb = pf_ext + (size_t)((b * H + hh) * 64) * 8192;
        const float gdec = MODE ? __expf(64.0f * log1pf(-exp2f(-5.0f - (float)hh))) : 1.0f;
        f32x16 S[4];
#pragma unroll
        for (int j = 0; j < 4; ++j)
#pragma unroll
            for (int i = 0; i < 16; ++i) S[j][i] = 0.f;
        unsigned rv[8]; u32x4 pf[4]; f32x16 oprev;
#define SC_SEG(c) (qseg0 + (size_t)((c) * 64) * (LD * 2))
#define SC_DMA(c) do { const char* _s = SC_SEG(c); const int _b = (c) & 1; \
            _Pragma("unroll") for (int i = 0; i < 4; ++i) __builtin_amdgcn_global_load_lds((const unsigned*)(_s + KOFF * 2 + (size_t)(2 * (4 * w + i)) * (LD * 2) + flo), (LAS unsigned*)(lds + KB_OFF + _b * 32768 + (4 * w + i) * 1024), 16, 0, 0); \
            _Pragma("unroll") for (int i = 0; i < 4; ++i) __builtin_amdgcn_global_load_lds((const unsigned*)(_s + (size_t)(2 * (4 * w + i)) * (LD * 2) + flo), (LAS unsigned*)(lds + QB_OFF + (4 * w + i) * 1024), 16, 0, 0); \
            if (MODE == 0 && w == 0) __builtin_amdgcn_global_load_lds((const unsigned*)(_s + AOFF * 2 + (size_t)16 * (LD * 2) + flo), (LAS unsigned*)(lds + EV2_OFF + _b * 1024), 16, 0, 0); } while (0)
#define SC_LOADV(c) do { const char* _v = (const char*)(vbase + (size_t)((c) * 64) * LD); \
            _Pragma("unroll") for (int i = 0; i < 8; ++i) rv[i] = __builtin_nontemporal_load((const unsigned*)(_v + (size_t)i * (LD * 2) + vlo)); } while (0)
#define SC_LOADP(c) do { _Pragma("unroll") for (int st = 0; st < 4; ++st) if (st < 2 || kh) { \
            if (MODE == 0) pf[st] = *(const u32x4*)(SC_SEG(c) + AOFF * 2 + (size_t)(2 * (4 * kh + st)) * (LD * 2) + flo); \
            else pf[st] = *(const u32x4*)(pfb + (size_t)(c) * 8192 + (4 * kh + st) * 1024 + lane * 16); } } while (0)
        SC_DMA(0); SC_LOADV(0); SC_LOADP(0);
        for (int c = 0; c < 64; ++c) {
            {
                u32x4 v0, v1;
                v0.x = (rv[0] & 0xffffu) | (rv[1] << 16); v0.y = (rv[2] & 0xffffu) | (rv[3] << 16); v0.z = (rv[4] & 0xffffu) | (rv[5] << 16); v0.w = (rv[6] & 0xffffu) | (rv[7] << 16);
                v1.x = (rv[0] >> 16) | (rv[1] & 0xffff0000u); v1.y = (rv[2] >> 16) | (rv[3] & 0xffff0000u); v1.z = (rv[4] >> 16) | (rv[5] & 0xffff0000u); v1.w = (rv[6] >> 16) | (rv[7] & 0xffff0000u);
                LAS unsigned char* vt = lds + VT2_OFF + ((2 * vp) * TSTR + 8 * s8) * 2;
                *(LAS u32x4*)(vt) = v0; *(LAS u32x4*)(vt + TSTR * 2) = v1;
            }
            asm volatile("s_waitcnt vmcnt(0)" ::: "memory");
            __syncthreads();
            if (c > 0) {
                char* op = (char*)(vbase + (size_t)((c - 1) * 64 + 32 * kh) * LD);
                const unsigned olo = ((unsigned)(4 * h2) * LD + 32 * vb + r) * 2u;
#pragma unroll
                for (int i = 0; i < 16; ++i) __builtin_nontemporal_store((bf16_t)(pk2(oprev[i], 0.f) & 0xffffu), (bf16_t*)(op + (size_t)((i & 3) + 8 * (i >> 2)) * (LD * 2) + olo));
            }
            if (c + 1 < 64) SC_LOADV(c + 1);
            f32x16 op0, op1;
#pragma unroll
            for (int i = 0; i < 16; ++i) { op0[i] = 0.f; op1[i] = 0.f; }
#pragma unroll
            for (int j = 0; j < 4; ++j) {
#pragma unroll
                for (int st = 0; st < 2; ++st) {
                    u32x4 sp; sp.x = pk2(S[j][8 * st + 0], S[j][8 * st + 1]); sp.y = pk2(S[j][8 * st + 2], S[j][8 * st + 3]); sp.z = pk2(S[j][8 * st + 4], S[j][8 * st + 5]); sp.w = pk2(S[j][8 * st + 6], S[j][8 * st + 7]);
                    const bf16x8 sfrag = __builtin_bit_cast(bf16x8, sp);
                    const LAS unsigned char* qf = lds + QB_OFF + ((((4 * kh + j) * 2 + st) * 2) * 1024) + lane * 16;
                    op0 = MFMA32(*(const LAS bf16x8*)(qf), sfrag, op0);
                    op1 = MFMA32(*(const LAS bf16x8*)(qf + 1024), sfrag, op1);
                }
            }
            __syncthreads();
            if (c + 1 < 64) SC_DMA(c + 1);
            f32x16 o;
#pragma unroll
            for (int i = 0; i < 16; ++i) { XCH[w * 1024 + i * 64 + lane] = kh ? op0[i] : op1[i]; o[i] = kh ? op1[i] : op0[i]; }
            bf16x8 vf[4];
#pragma unroll
            for (int st = 0; st < 4; ++st) vf[st] = *(const LAS bf16x8*)(lds + VT2_OFF + ((32 * vb + r) * TSTR + 16 * st + 8 * h2) * 2);
            o = MFMA32(__builtin_bit_cast(bf16x8, pf[0]), vf[0], o);
            o = MFMA32(__builtin_bit_cast(bf16x8, pf[1]), vf[1], o);
            if (kh) { o = MFMA32(__builtin_bit_cast(bf16x8, pf[2]), vf[2], o); o = MFMA32(__builtin_bit_cast(bf16x8, pf[3]), vf[3], o); }
            if (c + 1 < 64) SC_LOADP(c + 1);
            const LAS unsigned char* kfb = lds + KB_OFF + (c & 1) * 32768 + lane * 16;
            const LAS float* EVc = (const LAS float*)(lds + EV2_OFF + (c & 1) * 1024);
#pragma unroll
            for (int j = 0; j < 4; ++j) {
                const int kb = 4 * kh + j;
#pragma unroll
                for (int st = 0; st < 4; ++st) S[j] = MFMA32(*(const LAS bf16x8*)(kfb + (kb * 4 + st) * 1024), vf[st], S[j]);
                if (MODE == 0) {
#pragma unroll
                    for (int g4 = 0; g4 < 4; ++g4) { const f32x4 e = *(const LAS f32x4*)(EVc + 32 * kb + 8 * g4 + 4 * h2);
#pragma unroll
                        for (int q = 0; q < 4; ++q) S[j][4 * g4 + q] *= e[q]; }
                } else {
#pragma unroll
                    for (int i = 0; i < 16; ++i) S[j][i] *= gdec;
                }
            }
            __syncthreads();
#pragma unroll
            for (int i = 0; i < 16; ++i) oprev[i] = o[i] + XCH[(w ^ 4) * 1024 + i * 64 + lane];
        }
        {
            char* op = (char*)(vbase + (size_t)(63 * 64 + 32 * kh) * LD);
            const unsigned olo = ((unsigned)(4 * h2) * LD + 32 * vb + r) * 2u;
#pragma unroll
            for (int i = 0; i < 16; ++i) __builtin_nontemporal_store((bf16_t)(pk2(oprev[i], 0.f) & 0xffffu), (bf16_t*)(op + (size_t)((i & 3) + 8 * (i >> 2)) * (LD * 2) + olo));
        }
#undef SC_SEG
#undef SC_DMA
#undef SC_LOADV
#undef SC_LOADP
        asm volatile("s_waitcnt vmcnt(0)" ::: "memory");
        __syncthreads();
    }
}

template <int MODE>
__device__ __forceinline__ void ew_phase(bf16_t* proj, const float* gain, const float* bias, int gw, int NGW, int lane) {
    constexpr int H = MODE ? 8 : 4, DV = MODE ? 512 : 1024, LD = MODE ? N1 : N0, NC = DV / 512;
    constexpr int VOFF = MODE ? 4096 : 2048, GOFF = VOFF + DI;
    for (int p = gw; p < T * H; p += NGW) {
        const int t = p / H, hh = p % H;
        bf16_t* orow = proj + (size_t)t * LD + VOFF + hh * DV;
        const bf16_t* grow = proj + (size_t)t * LD + GOFF + hh * DV;
        u32x4 ov[NC], gv[NC];
#pragma unroll
        for (int cc = 0; cc < NC; ++cc) { ov[cc] = __builtin_nontemporal_load((const u32x4*)(orow + cc * 512 + lane * 8)); gv[cc] = __builtin_nontemporal_load((const u32x4*)(grow + cc * 512 + lane * 8)); }
        float s1 = 0.f, s2 = 0.f;
#pragma unroll
        for (int cc = 0; cc < NC; ++cc)
#pragma unroll
            for (int q = 0; q < 4; ++q) { const float oa = bflo(ov[cc][q]), ob = bfhi(ov[cc][q]); s1 += oa + ob; s2 += oa * oa + ob * ob; }
        s1 = wave_sum(s1); s2 = wave_sum(s2);
        float mu = 0.f, rs;
        if (MODE == 0) rs = rsqrtf(s2 * (1.0f / DV) + EPS);
        else { mu = s1 * (1.0f / DV); rs = rsqrtf(fmaxf(s2 * (1.0f / DV) - mu * mu, 0.f) + EPS); }
#pragma unroll
        for (int cc = 0; cc < NC; ++cc) {
            const int col = cc * 512 + lane * 8;
            const f32x4 g0 = *(const f32x4*)(gain + hh * DV + col), g1 = *(const f32x4*)(gain + hh * DV + col + 4);
            f32x4 b0 = (f32x4){0.f, 0.f, 0.f, 0.f}, b1 = b0;
            if (MODE == 1) { b0 = *(const f32x4*)(bias + hh * DV + col); b1 = *(const f32x4*)(bias + hh * DV + col + 4); }
            const float gg[8] = {g0[0], g0[1], g0[2], g0[3], g1[0], g1[1], g1[2], g1[3]}, bb[8] = {b0[0], b0[1], b0[2], b0[3], b1[0], b1[1], b1[2], b1[3]};
            u32x4 res;
#pragma unroll
            for (int q = 0; q < 4; ++q) {
                const float oa = bflo(ov[cc][q]), ob = bfhi(ov[cc][q]), ga = bflo(gv[cc][q]), gb = bfhi(gv[cc][q]);
                const float ya = ((oa - mu) * rs * gg[2 * q] + bb[2 * q]) * (ga / (1.0f + __expf(-ga)));
                const float yb = ((ob - mu) * rs * gg[2 * q + 1] + bb[2 * q + 1]) * (gb / (1.0f + __expf(-gb)));
                res[q] = pk2(ya, yb);
            }
            *(u32x4*)(orow + col) = res;
        }
    }
}

__device__ __forceinline__ void p0_transpose_item(const float* W, int K, int N, bf16_t* WT, int row_off, LAS float* scr, int item, int lane, const float* kvec, int sc0, int sc1, float sc) {
    const int nblk = N / 32, kb = item / nblk, nb = item % nblk, k0 = 64 * kb, n0 = 32 * nb;
    const float cs = (n0 >= sc0 && n0 < sc1) ? sc : 1.0f;
#pragma unroll 8
    for (int i = 0; i < 32; ++i) { const int kk = 2 * i + (lane >> 5); const float kv = kvec ? kvec[k0 + kk] : 1.0f; scr[kk * 33 + (lane & 31)] = __builtin_nontemporal_load(W + (size_t)(k0 + kk) * N + n0 + (lane & 31)) * (kv * cs); }
    asm volatile("s_waitcnt lgkmcnt(0)" ::: "memory");
    const int c = lane & 7;
#pragma unroll
    for (int j = 0; j < 4; ++j) { const int n = (lane >> 3) + 8 * j; const LAS float* s = scr + (8 * c) * 33 + n;
        u32x4 o; o.x = pk2(s[0 * 33], s[1 * 33]); o.y = pk2(s[2 * 33], s[3 * 33]); o.z = pk2(s[4 * 33], s[5 * 33]); o.w = pk2(s[6 * 33], s[7 * 33]);
        *(u32x4*)(WT + (size_t)(row_off + n0 + n) * K + k0 + 8 * c) = o; }
    asm volatile("s_waitcnt lgkmcnt(0)" ::: "memory");
}

#define XB_TMO      128
#define XB_XCNT(j)  (256  + 64 * (j))
#define XB_XSUB(j)  (1280 + 64 * (j))
#define XB_XGEN(j)  (2304 + 64 * (j))
#define XB_TOP      3328
#define XB_TOPGEN   3392
#define XCD_BAR_WORDS 3456
#define XB_SPIN_CAP (1u << 18)

__device__ __forceinline__ unsigned xb_ld(unsigned* p)              { return __hip_atomic_load(p, __ATOMIC_RELAXED, __HIP_MEMORY_SCOPE_AGENT); }
__device__ __forceinline__ unsigned xb_add(unsigned* p, unsigned v) { return __hip_atomic_fetch_add(p, v, __ATOMIC_RELAXED, __HIP_MEMORY_SCOPE_AGENT); }
__device__ __forceinline__ unsigned xb_xcc_id() { return (unsigned)__builtin_amdgcn_s_getreg((3 << 11) | 20) & 0xFu; }
#define XB_SPIN(cond, bar) do { unsigned _sp = 0; while (cond) { __builtin_amdgcn_s_sleep(1); \
    if ((++_sp & 255u) == 0u) { if (xb_ld(&(bar)[XB_TMO])) break; if (_sp > XB_SPIN_CAP) { atomicAdd(&(bar)[XB_TMO], 1u); break; } } } } while (0)

struct XcdBarrier {
    unsigned* bar; unsigned x;
    volatile LAS unsigned* st;
};

__device__ __forceinline__ XcdBarrier xcd_barrier_post(unsigned* bar, volatile LAS unsigned* st) {
    XcdBarrier b; b.bar = bar; b.x = xb_xcc_id(); b.st = st;
    if (threadIdx.x == 0) st[2] = xb_add(&bar[XB_XCNT(b.x)], 1u);
    return b;
}
__device__ __forceinline__ void xcd_barrier_complete(unsigned* bar, unsigned x, unsigned& nloc, unsigned& nx) {
    const unsigned G = gridDim.x * gridDim.y * gridDim.z;
    unsigned sum, cnt, mine, sp = 0u;
    for (;;) {
        sum = 0u; cnt = 0u; mine = 0u;
#pragma unroll
        for (unsigned j = 0; j < 16; ++j) { const unsigned c = xb_ld(&bar[XB_XCNT(j)]); sum += c; cnt += (c > 0u) ? 1u : 0u; mine = (j == x) ? c : mine; }
        if (sum == G) break;
        __builtin_amdgcn_s_sleep(1);
        if ((++sp & 255u) == 0u) { if (xb_ld(&bar[XB_TMO])) break; if (sp > XB_SPIN_CAP) { atomicAdd(&bar[XB_TMO], 1u); break; } }
    }
    nloc = mine > 0u ? mine : 1u; nx = cnt > 0u ? cnt : 1u;
}

__device__ __forceinline__ void xcd_barrier(const XcdBarrier& b) {
    asm volatile("s_waitcnt vmcnt(0)" ::: "memory");
    __syncthreads();
    if (threadIdx.x == 0) {
        unsigned* bar = b.bar;
        __builtin_amdgcn_s_waitcnt(0);
        unsigned nloc = b.st[0], nx = b.st[1];
        if (nloc == 0u) { xcd_barrier_complete(bar, b.x, nloc, nx); b.st[0] = nloc; b.st[1] = nx; }
        const unsigned old = xb_add(&bar[XB_XSUB(b.x)], 1u);
        const unsigned gen = old / nloc;
        if (old + 1u == (gen + 1u) * nloc) {
            __builtin_amdgcn_fence(__ATOMIC_RELEASE, "agent");
            asm volatile("s_waitcnt vmcnt(0)" ::: "memory");
            const unsigned og = xb_add(&bar[XB_TOP], 1u);
            const unsigned tg = og / nx;
            if (og + 1u == (tg + 1u) * nx) xb_add(&bar[XB_TOPGEN], 1u);
            else XB_SPIN(xb_ld(&bar[XB_TOPGEN]) == tg, bar);
            __builtin_amdgcn_fence(__ATOMIC_ACQUIRE, "agent");
            xb_add(&bar[XB_XGEN(b.x)], 1u);
            asm volatile("s_waitcnt vmcnt(0)" ::: "memory");
        } else {
            XB_SPIN(xb_ld(&bar[XB_XGEN(b.x)]) == gen, bar);
            __builtin_amdgcn_fence(__ATOMIC_ACQUIRE, "agent");
            asm volatile("s_waitcnt vmcnt(0)" ::: "memory");
        }
    }
    __syncthreads();
}

struct Args {
    const float* x; const int* pos;
    const float *gla_norm, *gla_w_in, *gla_w_a1, *gla_w_a2, *gla_b_a, *gla_head_g, *gla_w_out;
    const float *ret_norm, *ret_w_in, *ret_gn_g, *ret_gn_b, *ret_w_out, *final_norm;
    float* out; unsigned char* ws;
};

__global__ void __launch_bounds__(512, 2) fwd(Args a) {
    extern __shared__ __attribute__((aligned(16))) unsigned char lds_raw[];
    LAS unsigned char* lds = (LAS unsigned char*)lds_raw;
    cg::grid_group grid = cg::this_grid();
    const int tid = threadIdx.x, lane = tid & 63, wave = __builtin_amdgcn_readfirstlane(tid >> 6);
    const int G = gridDim.x, bx = blockIdx.x;
    const int vcu = (G % 8 == 0) ? (bx % 8) * (G / 8) + bx / 8 : bx;
    const int gw = vcu * 8 + wave, NGW = G * 8;
    const int gtid = bx * 512 + tid, NGT = G * 512;
    unsigned char* ws = a.ws;
    if (tid < 4) ((LAS unsigned*)(lds + LDS_BARW))[tid] = 0u;
    __syncthreads();
    XcdBarrier xbar = xcd_barrier_post((unsigned*)(ws + WS_BAR), (volatile LAS unsigned*)(lds + LDS_BARW));
    bf16_t* W0T = (bf16_t*)(ws + WS_W0T); bf16_t* WOUT0T = (bf16_t*)(ws + WS_WOUT0T); bf16_t* W1T = (bf16_t*)(ws + WS_W1T); bf16_t* WOUT1T = (bf16_t*)(ws + WS_WOUT1T);
    bf16_t* H1BF = (bf16_t*)(ws + WS_H1BF); bf16_t* PROJ = (bf16_t*)(ws + WS_PROJ);
    bf16_t* HN = (bf16_t*)a.out;
    f32x2* ROT = (f32x2*)(ws + WS_ROT); float* SUMSQ1 = (float*)(ws + WS_SUMSQ1);

#ifdef PROBE_A
    unsigned long long* TS = (unsigned long long*)(ws + 60 * MiB);
    int nst = 0;
#define STAMP() do { if (bx == 0 && tid == 0) TS[nst] = __builtin_amdgcn_s_memrealtime(); ++nst; } while (0)
#else
#define STAMP() do {} while (0)
#endif
    STAMP();
    {
        LAS float* scr = (LAS float*)(lds + wave * 8704);
        constexpr int I_W0 = (D / 64) * (10240 / 32), I_WO = (DI / 64) * (D / 32), I_W1 = (D / 64) * (N1 / 32);
        constexpr int NITEMS = I_W0 + I_WO + I_W1 + I_WO;
        for (int it = gw; it < NITEMS; it += NGW) {
            int q = it;
            if (q < I_W0) { p0_transpose_item(a.gla_w_in, D, 10240, W0T, 0, scr, q, lane, nullptr, 0, 1024, 0.0625f); continue; } q -= I_W0;
            if (q < I_WO) { p0_transpose_item(a.gla_w_out, DI, D, WOUT0T, 0, scr, q, lane, nullptr, 0, 0, 1.0f); continue; } q -= I_WO;
            if (q < I_W1) { p0_transpose_item(a.ret_w_in, D, N1, W1T, 0, scr, q, lane, a.ret_norm, 2048, 4096, 0.0625f); continue; } q -= I_W1;
            p0_transpose_item(a.ret_w_out, DI, D, WOUT1T, 0, scr, q, lane, nullptr, 0, 0, 1.0f);
        }
        for (int idx = gtid; idx < 1024 * 256; idx += NGT) {
            const int n = idx >> 8, kc = idx & 255;
            float a2[16];
#pragma unroll
            for (int rr = 0; rr < 16; ++rr) a2[rr] = a.gla_w_a2[rr * 1024 + n];
            float res[8];
#pragma unroll
            for (int kk = 0; kk < 8; ++kk) {
                const f32x4* p = (const f32x4*)(a.gla_w_a1 + (size_t)(8 * kc + kk) * 16);
                const f32x4 p0 = p[0], p1 = p[1], p2 = p[2], p3 = p[3];
                res[kk] = p0[0] * a2[0] + p0[1] * a2[1] + p0[2] * a2[2] + p0[3] * a2[3] + p1[0] * a2[4] + p1[1] * a2[5] + p1[2] * a2[6] + p1[3] * a2[7]
                        + p2[0] * a2[8] + p2[1] * a2[9] + p2[2] * a2[10] + p2[3] * a2[11] + p3[0] * a2[12] + p3[1] * a2[13] + p3[2] * a2[14] + p3[3] * a2[15];
            }
            *(u32x4*)(W0T + (size_t)(10240 + n) * D + 8 * kc) = (u32x4){pk2(res[0], res[1]), pk2(res[2], res[3]), pk2(res[4], res[5]), pk2(res[6], res[7])};
        }
        for (int m = gw; m < T; m += NGW) {
            const f32x4* xr = (const f32x4*)(a.x + (size_t)m * D) + lane;
            const f32x4* gr = (const f32x4*)a.gla_norm + lane;
            f32x4 v[8]; float s = 0.f;
#pragma unroll
            for (int j = 0; j < 8; ++j) { v[j] = __builtin_nontemporal_load(xr + 64 * j); s += (v[j][0] * v[j][0] + v[j][1] * v[j][1]) + (v[j][2] * v[j][2] + v[j][3] * v[j][3]); }
            const float rs = rsqrtf(wave_sum(s) * (1.0f / D) + EPS);
            u32x2* o8 = (u32x2*)(HN + (size_t)m * D) + lane;
#pragma unroll
            for (int j = 0; j < 8; ++j) { const f32x4 g = gr[64 * j]; o8[64 * j] = (u32x2){pk2(v[j][0] * rs * g[0], v[j][1] * rs * g[1]), pk2(v[j][2] * rs * g[2], v[j][3] * rs * g[3])}; }
        }
    }
    if (a.ws == nullptr) grid.sync();
    xcd_barrier(xbar); STAMP();
    int pcu;
    {
        volatile LAS unsigned* bst = (volatile LAS unsigned*)(lds + LDS_BARW);
        if (tid == 0) {
            const unsigned* bw = (const unsigned*)(ws + WS_BAR);
            unsigned base = 0u;
            for (unsigned j = 0; j < 16; ++j) { const unsigned cj = __hip_atomic_load(bw + XB_XCNT(j), __ATOMIC_RELAXED, __HIP_MEMORY_SCOPE_AGENT); if (j < xbar.x) base += cj; }
            bst[3] = base + bst[2];
        }
        __syncthreads();
        pcu = (int)bst[3];
        if (pcu < 0 || pcu >= G) pcu = vcu;
    }
    {
        pg8::Gemm g{HN, W0T, T, N0, D, D}; pg8::StaticOrder S; S.init(T, N0, G, bx);
        pg8::EpiProj E{PROJ, N0, 0, nullptr, a.gla_b_a, nullptr};
        pg8::gemm_phase<pg8::EpiProj>(lds, g, S, E);
    }
    xcd_barrier(xbar); STAMP();
    prescan_phase<0>(lds, PROJ, nullptr, pcu, G);
    xcd_barrier(xbar); STAMP();
    scan_phase<0>(lds, PROJ, nullptr, pcu, G);
    xcd_barrier(xbar); STAMP();
    {
        ew_phase<0>(PROJ, a.gla_head_g, nullptr, gw, NGW, lane);
        for (int idx = gtid; idx < T * 128; idx += NGT) {
            const int t = idx >> 7, i = idx & 127;
            const double invf = exp(-(double)i * (9.210340371976184 / 128.0));
            const double ang = (double)a.pos[t] * invf;
            double rev = ang * 0.15915494309189535; rev -= floor(rev);
            const float fr = (float)rev;
            ROT[idx] = (f32x2){__builtin_amdgcn_cosf(fr), __builtin_amdgcn_sinf(fr)};
        }
        for (int idx = gtid; idx < T; idx += NGT) SUMSQ1[idx] = 0.f;
    }
    xcd_barrier(xbar); STAMP();
    {
        pg8::Gemm g{PROJ + 2048, WOUT0T, T, D, DI, N0}; pg8::StaticOrder S; S.init(T, D, G, bx);
        pg8::EpiOut E{a.x, nullptr, H1BF, SUMSQ1};
        pg8::gemm_phase<pg8::EpiOut>(lds, g, S, E);
    }
    xcd_barrier(xbar); STAMP();
    {
        pg8::Gemm g{H1BF, W1T, T, N1, D, D}; pg8::StaticOrder S; S.init(T, N1, G, bx);
        pg8::EpiProj E{PROJ, N1, 1, SUMSQ1, nullptr, ROT};
        pg8::gemm_phase<pg8::EpiProj>(lds, g, S, E);
    }
    xcd_barrier(xbar); STAMP();
    prescan_phase<1>(lds, PROJ, ws + WS_ROT, pcu, G);
    xcd_barrier(xbar); STAMP();
    scan_phase<1>(lds, PROJ, ws + WS_ROT, pcu, G);
    xcd_barrier(xbar); STAMP();
    ew_phase<1>(PROJ, a.ret_gn_g, a.ret_gn_b, gw, NGW, lane);
    xcd_barrier(xbar); STAMP();
    {
        pg8::Gemm g{PROJ + 4096, WOUT1T, T, D, DI, N1}; pg8::StaticOrder S; S.init(T, D, G, bx);
        pg8::EpiOut E{nullptr, H1BF, H1BF, nullptr};
        pg8::gemm_phase<pg8::EpiOut>(lds, g, S, E);
    }
    xcd_barrier(xbar); STAMP();
    for (int m = gw; m < T; m += NGW) {
        const u32x4* hr = (const u32x4*)(H1BF + (size_t)m * D) + lane;
        u32x4 hv[4]; float s = 0.f;
#pragma unroll
        for (int j = 0; j < 4; ++j) { hv[j] = __builtin_nontemporal_load(hr + 64 * j);
#pragma unroll
            for (int q = 0; q < 4; ++q) { const float lo = bflo(hv[j][q]), hi = bfhi(hv[j][q]); s += lo * lo + hi * hi; } }
        const float rs = rsqrtf(wave_sum(s) * (1.0f / D) + EPS);
#pragma unroll
        for (int j = 0; j < 4; ++j) {
            const int col = 512 * j + 8 * lane;
            const f32x4 g0 = *(const f32x4*)(a.final_norm + col), g1 = *(const f32x4*)(a.final_norm + col + 4);
            f32x4 y0 = (f32x4){bflo(hv[j][0]), bfhi(hv[j][0]), bflo(hv[j][1]), bfhi(hv[j][1])} * rs * g0;
            f32x4 y1 = (f32x4){bflo(hv[j][2]), bfhi(hv[j][2]), bflo(hv[j][3]), bfhi(hv[j][3])} * rs * g1;
            __builtin_nontemporal_store(y0, (f32x4*)(a.out + (size_t)m * D + col)); __builtin_nontemporal_store(y1, (f32x4*)(a.out + (size_t)m * D + col + 4));
        }
    }
}

extern "C" void kernel_launch(void* const* d_in, const int* in_sizes, int n_in, void* d_out, int out_size, void* d_ws, size_t ws_size, hipStream_t stream) {
    static int grid = 0;
    if (grid == 0) {
        int dev = 0, cus = 0, per_cu = 0;
        (void)hipGetDevice(&dev);
        (void)hipDeviceGetAttribute(&cus, hipDeviceAttributeMultiprocessorCount, dev);
        (void)hipFuncSetAttribute((const void*)fwd, hipFuncAttributeMaxDynamicSharedMemorySize, LDS_BYTES);
        (void)hipOccupancyMaxActiveBlocksPerMultiprocessor(&per_cu, (const void*)fwd, 512, LDS_BYTES);
        if (per_cu < 1) per_cu = 1;
        grid = cus * per_cu;
        if (ws_size < 1024 * MiB) fprintf(stderr, "kernel_launch: workspace too small (%zu)\n", ws_size);
    }
    Args a{};
    a.x = (const float*)d_in[0]; a.pos = (const int*)d_in[1];
    a.gla_norm = (const float*)d_in[2]; a.gla_w_in = (const float*)d_in[3]; a.gla_w_a1 = (const float*)d_in[4]; a.gla_w_a2 = (const float*)d_in[5];
    a.gla_b_a = (const float*)d_in[6]; a.gla_head_g = (const float*)d_in[7]; a.gla_w_out = (const float*)d_in[8];
    a.ret_norm = (const float*)d_in[9]; a.ret_w_in = (const float*)d_in[10]; a.ret_gn_g = (const float*)d_in[11]; a.ret_gn_b = (const float*)d_in[12];
    a.ret_w_out = (const float*)d_in[13]; a.final_norm = (const float*)d_in[14];
    a.out = (float*)d_out; a.ws = (unsigned char*)d_ws;
    (void)hipMemsetAsync((char*)d_ws + WS_BAR, 0, WS_BAR_BYTES, stream);
    void* args[] = {&a};
    hipError_t e = hipLaunchCooperativeKernel((const void*)fwd, dim3(grid), dim3(512), args, LDS_BYTES, stream);
    if (e != hipSuccess) fprintf(stderr, "cooperative launch failed: %s (grid %d)\n", hipGetErrorString(e), grid);
}
```

```cpp
#include <hip/hip_runtime.h>
#include <hip/hip_cooperative_groups.h>
#include <cstdio>
#include <cstdint>
namespace cg = cooperative_groups;

#define LAS __attribute__((address_space(3)))
typedef unsigned short bf16_t;
typedef short bf16x8 __attribute__((ext_vector_type(8)));
typedef short s16x4 __attribute__((ext_vector_type(4)));
typedef float f32x4 __attribute__((ext_vector_type(4)));
typedef float f32x2 __attribute__((ext_vector_type(2)));
typedef float f32x16 __attribute__((ext_vector_type(16)));
typedef unsigned u32x4 __attribute__((ext_vector_type(4)));
typedef unsigned u32x2 __attribute__((ext_vector_type(2)));
typedef __bf16 bf2_t __attribute__((ext_vector_type(2)));

constexpr int T = 32768, D = 2048, DI = 4096, SEQ = 4096;
constexpr int N0 = 11264, N1 = 12288;
constexpr float EPS = 1e-6f;
constexpr size_t MiB = 1u << 20;
constexpr size_t WS_W0T = 0, WS_WOUT0T = 44 * MiB, WS_W1T = 64 * MiB, WS_WOUT1T = 112 * MiB, WS_H1BF = 128 * MiB, WS_PROJ = 256 * MiB;
constexpr size_t WS_ROT = 0, WS_SUMSQ1 = 32 * MiB;
constexpr int LDS_BYTES = 155648, LDS_BARW = 155584;
constexpr size_t WS_BAR = 60 * MiB, WS_BAR_BYTES = 16384;

__device__ __forceinline__ unsigned pk2(float lo, float hi) { bf2_t r = __builtin_convertvector((f32x2){lo, hi}, bf2_t); return __builtin_bit_cast(unsigned, r); }
__device__ __forceinline__ float bflo(unsigned u) { return __builtin_bit_cast(float, u << 16); }
__device__ __forceinline__ float bfhi(unsigned u) { return __builtin_bit_cast(float, u & 0xffff0000u); }
__device__ __forceinline__ float wave_sum(float v) {
#pragma unroll
    for (int o = 1; o < 64; o <<= 1) v += __shfl_xor(v, o);
    return v;
}

namespace pg8 {
constexpr int BM = 256, BK = 64, HALF = 128, HTB = HALF * BK * 2, STAGE_BYTES = 8 * HTB, NXCD = 8, WGM = 8;
__host__ __device__ __forceinline__ int lds_byte(int r, int c) { const int st = (r >> 4) * 2 + (c >> 5), rr = r & 15, cc = c & 31, ob = rr * 64 + cc * 2; return st * 1024 + (ob ^ (((ob >> 9) & 1) << 5)); }
__host__ __device__ __forceinline__ void stage_rc(int b, int& R, int& C) { const int st = b / 1024, sb = b % 1024, swz = sb ^ (((sb >> 9) & 1) << 5); R = (st >> 1) * 16 + swz / 64; C = (st & 1) * 32 + (swz % 64) / 2; }
__host__ __device__ __forceinline__ int perm32(int rho) { const int n = rho >> 4, i = rho & 15; return 8 * (i >> 2) + 4 * n + (i & 3); }

struct Unit { int pm, pn; };
struct Gemm { const bf16_t* A; const bf16_t* Bt; int M, N, K, lda; };

struct StaticOrder {
    int nM, nN, nwg, G, c;
    __device__ void init(int M, int N, int G_, int c_) { nM = M / BM; nN = N / BM; nwg = nM * nN; G = G_; c = c_; }
    __device__ bool next(int i, Unit& u) const {
        const long L = (long)i * G + c; if (L >= nwg) return false;
        int wgid = (int)L; { const int q = nwg / NXCD, r = nwg % NXCD, xcd = wgid % NXCD, off = wgid / NXCD; wgid = (xcd < r ? xcd * (q + 1) : r * (q + 1) + (xcd - r) * q) + off; }
        const int nig = WGM * nN, gid = wgid / nig, fm = gid * WGM, gsz = (nM - fm) < WGM ? (nM - fm) : WGM;
        u.pm = fm + ((wgid % nig) % gsz); u.pn = (wgid % nig) / gsz; return true;
    }
};


struct EpiProj {
    static constexpr bool PERM = true;
    bf16_t* O; int ldc; int mode;
    const float* rowsumsq;
    const float* b_a;
    const f32x2* rot;
    __device__ __forceinline__ void operator()(const f32x4 (&acc)[2][2][4][2], const Unit& u, int wr, int wc, int fr, int fq) const {
        const int row0 = u.pm * BM + wr * 64 + fr, col0 = u.pn * BM + wc * 32 + 8 * fq;
        const bool is_a = (mode == 0) && (u.pn >= 40);
        const bool is_rot = (mode == 1) && (u.pn < 16);
        f32x4 bv[2][2];
#pragma unroll
        for (int bj = 0; bj < 2; ++bj)
#pragma unroll
            for (int n = 0; n < 2; ++n) bv[bj][n] = is_a ? *(const f32x4*)(b_a + (col0 - 10240) + bj * HALF + 4 * n) : (f32x4){0.f, 0.f, 0.f, 0.f};
#pragma unroll
        for (int ai = 0; ai < 2; ++ai)
#pragma unroll
            for (int m = 0; m < 4; ++m) {
                const int row = row0 + ai * HALF + m * 16;
                const float rs = rowsumsq ? rsqrtf(rowsumsq[row] * (1.0f / D) + EPS) : 1.0f;
                f32x4 v[2][2];
#pragma unroll
                for (int bj = 0; bj < 2; ++bj)
#pragma unroll
                    for (int n = 0; n < 2; ++n) v[bj][n] = acc[ai][bj][m][n] * rs;
                if (is_a) {
#pragma unroll
                    for (int bj = 0; bj < 2; ++bj)
#pragma unroll
                        for (int n = 0; n < 2; ++n)
#pragma unroll
                            for (int j = 0; j < 4; ++j) { const float x = v[bj][n][j] + bv[bj][n][j]; v[bj][n][j] = (fminf(x, 0.f) - __logf(1.0f + __expf(-fabsf(x)))) * (1.0f / 16.0f); }
                }
                if (is_rot) {
                    const f32x2* rp = rot + (size_t)row * 128 + wc * 32 + 8 * fq;
#pragma unroll
                    for (int n = 0; n < 2; ++n) {
                        const f32x4 t0 = *(const f32x4*)(rp + 4 * n), t1 = *(const f32x4*)(rp + 4 * n + 2);
                        const float cs[4] = {t0[0], t0[2], t1[0], t1[2]}, sn[4] = {t0[1], t0[3], t1[1], t1[3]};
#pragma unroll
                        for (int j = 0; j < 4; ++j) { const float x1 = v[0][n][j], x2 = v[1][n][j]; v[0][n][j] = x1 * cs[j] - x2 * sn[j]; v[1][n][j] = x2 * cs[j] + x1 * sn[j]; }
                    }
                }
                bf16_t* rowp = O + (size_t)row * ldc + col0;
#pragma unroll
                for (int bj = 0; bj < 2; ++bj) {
                    u32x4 w; w.x = pk2(v[bj][0][0], v[bj][0][1]); w.y = pk2(v[bj][0][2], v[bj][0][3]); w.z = pk2(v[bj][1][0], v[bj][1][1]); w.w = pk2(v[bj][1][2], v[bj][1][3]);
                    *(u32x4*)(rowp + bj * HALF) = w;
                }
            }
    }
};
struct EpiOut {
    static constexpr bool PERM = true;
    const float* resid32; const bf16_t* resid16; bf16_t* out16; float* sumsq;
    __device__ __forceinline__ void operator()(const f32x4 (&acc)[2][2][4][2], const Unit& u, int wr, int wc, int fr, int fq) const {
        const int row0 = u.pm * BM + wr * 64 + fr, col0 = u.pn * BM + wc * 32 + 8 * fq;
#pragma unroll
        for (int ai = 0; ai < 2; ++ai)
#pragma unroll
            for (int m = 0; m < 4; ++m) {
                const int row = row0 + ai * HALF + m * 16;
                const size_t off = (size_t)row * D + col0;
                float ss = 0.f;
#pragma unroll
                for (int bj = 0; bj < 2; ++bj) {
                    f32x4 r0, r1;
                    if (resid32) { r0 = __builtin_nontemporal_load((const f32x4*)(resid32 + off + bj * HALF)); r1 = __builtin_nontemporal_load((const f32x4*)(resid32 + off + bj * HALF + 4)); }
                    else { const u32x4 rr = *(const u32x4*)(resid16 + off + bj * HALF);
                           r0 = (f32x4){bflo(rr.x), bfhi(rr.x), bflo(rr.y), bfhi(rr.y)}; r1 = (f32x4){bflo(rr.z), bfhi(rr.z), bflo(rr.w), bfhi(rr.w)}; }
                    const f32x4 v0 = acc[ai][bj][m][0] + r0, v1 = acc[ai][bj][m][1] + r1;
                    ss += ((v0[0] * v0[0] + v0[1] * v0[1]) + (v0[2] * v0[2] + v0[3] * v0[3])) + ((v1[0] * v1[0] + v1[1] * v1[1]) + (v1[2] * v1[2] + v1[3] * v1[3]));
                    u32x4 w; w.x = pk2(v0[0], v0[1]); w.y = pk2(v0[2], v0[3]); w.z = pk2(v1[0], v1[1]); w.w = pk2(v1[2], v1[3]);
                    *(u32x4*)(out16 + off + bj * HALF) = w;
                }
                if (sumsq) { ss += __shfl_xor(ss, 16); ss += __shfl_xor(ss, 32); if (fq == 0) atomicAdd(sumsq + row, ss); }
            }
    }
};

template <class Epi>
__device__ __forceinline__ void gemm_phase(LAS unsigned char* lds, const Gemm g, const StaticOrder& S, const Epi& E) {
    const int tid = threadIdx.x, wid = __builtin_amdgcn_readfirstlane(tid >> 6), lane = tid & 63, wr = wid >> 2, wc = wid & 3, fr = lane & 15, fq = lane >> 4;
    const int K = g.K, nt = K / BK, lda = g.lda;
    unsigned voffA[2], voffB[2];
#pragma unroll
    for (int i = 0; i < 2; ++i) { int R, C; stage_rc(tid * 16 + i * 8192, R, C); const int Rb = Epi::PERM ? ((R & ~31) + perm32(R & 31)) : R;
        voffA[i] = (unsigned)(R * lda + C) * 2u; voffB[i] = (unsigned)(Rb * K + C) * 2u; }
    const size_t kstep = (size_t)(BK * 2);
    const size_t hstepA = (size_t)HALF * lda * 2, hstepB = (size_t)HALF * K * 2;
    const size_t tstepA = 2 * hstepA, tstepB = 2 * hstepB;
    const unsigned ldsw = (unsigned)wid * 1024u;
    const int aoff = lds_byte(wr * 64 + fr, fq * 8), boff = lds_byte(wc * 32 + fr, fq * 8);
#define PG8_SA(b, h) (((b) * 2 + (h)) * HTB)
#define PG8_SB(b, h) ((4 + (b) * 2 + (h)) * HTB)
#define PG8_STAGE(bufoff, gbase, voff) do { _Pragma("unroll") for (int _i = 0; _i < 2; ++_i) \
        __builtin_amdgcn_global_load_lds((const unsigned*)((const char*)(gbase) + (voff)[_i]), (LAS unsigned*)(lds + (bufoff) + ldsw + _i * 8192), 16, 0, 0); } while (0)
#define PG8_LDA(dst, b, h) do { _Pragma("unroll") for (int m = 0; m < 4; ++m) _Pragma("unroll") for (int k = 0; k < 2; ++k) dst[m][k] = *(const LAS bf16x8*)(lds + PG8_SA(b, h) + aoff + m * 2048 + k * 1024); } while (0)
#define PG8_LDB(dst, b, h) do { _Pragma("unroll") for (int n = 0; n < 2; ++n) _Pragma("unroll") for (int k = 0; k < 2; ++k) dst[n][k] = *(const LAS bf16x8*)(lds + PG8_SB(b, h) + boff + n * 2048 + k * 1024); } while (0)
#define PG8_MMA(ai, bj, At, Bt) do { __builtin_amdgcn_s_setprio(1); _Pragma("unroll") for (int m = 0; m < 4; ++m) _Pragma("unroll") for (int n = 0; n < 2; ++n) _Pragma("unroll") for (int k = 0; k < 2; ++k) \
        acc[ai][bj][m][n] = __builtin_amdgcn_mfma_f32_16x16x32_bf16(Bt[n][k], At[m][k], acc[ai][bj][m][n], 0, 0, 0); __builtin_amdgcn_s_setprio(0); } while (0)
#define PG8_WAIT_V(n) asm volatile("s_waitcnt vmcnt(" #n ")" ::: "memory")
#define PG8_WAIT_L(n) asm volatile("s_waitcnt lgkmcnt(" #n ")" ::: "memory")
#define PG8_BAR __builtin_amdgcn_s_barrier()
#define PG8_SCHED __builtin_amdgcn_sched_barrier(0)
    Unit cur, nxt; int ui = 0;
    if (!S.next(0, cur)) return;
    f32x4 acc[2][2][4][2];
#pragma unroll
    for (int a = 0; a < 2; ++a)
#pragma unroll
        for (int b = 0; b < 2; ++b)
#pragma unroll
            for (int m = 0; m < 4; ++m)
#pragma unroll
                for (int n = 0; n < 2; ++n) acc[a][b][m][n] = (f32x4){0.f, 0.f, 0.f, 0.f};
    bf16x8 At[4][2], B0[2][2], B1[2][2];
    const char* cA = (const char*)g.A + (size_t)cur.pm * tstepA; const char* cB = (const char*)g.Bt + (size_t)cur.pn * tstepB;
    PG8_STAGE(PG8_SB(0, 0), cB, voffB); PG8_STAGE(PG8_SB(0, 1), cB + hstepB, voffB); PG8_STAGE(PG8_SA(0, 0), cA, voffA); PG8_STAGE(PG8_SA(0, 1), cA + hstepA, voffA);
    if (wr == 1) PG8_BAR;
    PG8_WAIT_V(2); PG8_BAR;
    PG8_STAGE(PG8_SB(1, 0), cB + kstep, voffB); PG8_STAGE(PG8_SA(1, 0), cA + kstep, voffA); PG8_STAGE(PG8_SB(1, 1), cB + hstepB + kstep, voffB);
    PG8_WAIT_V(6); PG8_BAR;
    for (;;) {
        const bool has_next = S.next(ui + 1, nxt);
        const char* nA = has_next ? (const char*)g.A + (size_t)nxt.pm * tstepA : cA; const char* nB = has_next ? (const char*)g.Bt + (size_t)nxt.pn * tstepB : cB;
        for (int t = 0; t < nt; t += 2) {
            const bool last = (t == nt - 2);
            const char* a1 = cA + (size_t)(t + 1) * kstep;
            const char* a2 = last ? nA : cA + (size_t)(t + 2) * kstep; const char* b2 = last ? nB : cB + (size_t)(t + 2) * kstep;
            const char* a3 = a2 + kstep; const char* b3 = b2 + kstep;
            PG8_LDB(B0, 0, 0); PG8_LDB(B1, 0, 1); PG8_SCHED; PG8_LDA(At, 0, 0); PG8_STAGE(PG8_SA(1, 1), a1 + hstepA, voffA);
            PG8_WAIT_V(8); PG8_WAIT_L(0); PG8_BAR; PG8_MMA(0, 0, At, B0); PG8_MMA(0, 1, At, B1); PG8_BAR; PG8_SCHED;
            PG8_LDA(At, 0, 1); PG8_STAGE(PG8_SB(0, 0), b2, voffB); PG8_STAGE(PG8_SB(0, 1), b2 + hstepB, voffB); PG8_STAGE(PG8_SA(0, 0), a2, voffA);
            PG8_WAIT_V(8); PG8_WAIT_L(0); PG8_BAR; PG8_MMA(1, 0, At, B0); PG8_MMA(1, 1, At, B1); PG8_BAR; PG8_SCHED;
            PG8_LDB(B0, 1, 0); PG8_LDB(B1, 1, 1); PG8_SCHED; PG8_LDA(At, 1, 0); PG8_STAGE(PG8_SA(0, 1), a2 + hstepA, voffA);
            PG8_WAIT_V(8); PG8_WAIT_L(0); PG8_BAR; PG8_MMA(0, 0, At, B0); PG8_MMA(0, 1, At, B1); PG8_BAR; PG8_SCHED;
            PG8_LDA(At, 1, 1); PG8_STAGE(PG8_SB(1, 0), b3, voffB); PG8_STAGE(PG8_SB(1, 1), b3 + hstepB, voffB); PG8_STAGE(PG8_SA(1, 0), a3, voffA);
            PG8_WAIT_V(8); PG8_WAIT_L(0); PG8_BAR; PG8_MMA(1, 0, At, B0); PG8_MMA(1, 1, At, B1); PG8_BAR; PG8_SCHED;
        }
        if (wr == 0) PG8_BAR;
        E(acc, cur, wr, wc, fr, fq);
        if (!has_next) break;
#pragma unroll
        for (int a = 0; a < 2; ++a)
#pragma unroll
            for (int b = 0; b < 2; ++b)
#pragma unroll
                for (int m = 0; m < 4; ++m)
#pragma unroll
                    for (int n = 0; n < 2; ++n) acc[a][b][m][n] = (f32x4){0.f, 0.f, 0.f, 0.f};
        cur = nxt; cA = nA; cB = nB; ++ui;
        if (wr == 1) PG8_BAR;
    }
    PG8_WAIT_V(0);
    PG8_BAR;
#undef PG8_SA
#undef PG8_SB
#undef PG8_STAGE
#undef PG8_LDA
#undef PG8_LDB
#undef PG8_MMA
#undef PG8_WAIT_V
#undef PG8_WAIT_L
#undef PG8_BAR
#undef PG8_SCHED
}
}

constexpr int QT_OFF = 0, KH_OFF = 33792, KT_OFF = 67584, VT_OFF = 104448, PB_OFF = 122880, EV_OFF = 132096, TOT_OFF = 133120;
constexpr int QSTR = 264, TSTR = 72;
#define MFMA32(a, b, c) __builtin_amdgcn_mfma_f32_32x32x16_bf16((a), (b), (c), 0, 0, 0)
__device__ __forceinline__ int crow(int i, int h) { return (i & 3) + 8 * (i >> 2) + 4 * h; }

template <int MODE>
__device__ __forceinline__ void prescan_phase(LAS unsigned char* lds, bf16_t* proj, unsigned char* pf_ext, int vcu, int G) {
    constexpr int H = MODE ? 8 : 4, LD = MODE ? N1 : N0, KOFF = MODE ? 2048 : 1024, AOFF = 10240, NIT = 8 * H * 64;
    const int tid = threadIdx.x, lane = tid & 63, w = __builtin_amdgcn_readfirstlane(tid >> 6);
    const int r = lane & 31, h2 = lane >> 5;
    const int cp = tid & 127, sq = w >> 1;
    LAS float* EV = (LAS float*)(lds + EV_OFF);
    LAS float* TOT = (LAS float*)(lds + TOT_OFF);
    const unsigned qlo = ((unsigned)(16 * sq) * LD + 2 * cp) * 2u;
    const unsigned flo = (unsigned)h2 * (LD * 2) + r * 16;
    unsigned rq[16], rk[16], ra[16];
#define PRE_BASE(it) (proj + ((size_t)((it) / (64 * H)) * SEQ + (size_t)((it) % 64) * 64) * LD + (((it) / 64) % H) * 256)
#define PRE_LOAD(it) do { const char* _p = (const char*)PRE_BASE(it); \
        _Pragma("unroll") for (int i = 0; i < 16; ++i) { const char* _pi = _p + (size_t)i * (LD * 2); \
            rq[i] = __builtin_nontemporal_load((const unsigned*)(_pi + qlo)); rk[i] = __builtin_nontemporal_load((const unsigned*)(_pi + KOFF * 2 + qlo)); \
            if (MODE == 0) ra[i] = __builtin_nontemporal_load((const unsigned*)(_pi + AOFF * 2 + qlo)); } } while (0)
    if (vcu < NIT) PRE_LOAD(vcu);
    for (int item = vcu; item < NIT; item += G) {
        const int hh = (item / 64) % H;
        char* qseg = (char*)PRE_BASE(item);
        const float lg = MODE ? log1pf(-exp2f(-5.0f - (float)hh)) : 0.f;
        float run0 = 0.f, run1 = 0.f;
        if (MODE == 0) {
            float a0 = 0.f, a1 = 0.f;
#pragma unroll
            for (int i = 0; i < 16; ++i) { a0 += bflo(ra[i]); a1 += bfhi(ra[i]); }
            *(LAS f32x2*)(TOT + sq * 256 + 2 * cp) = (f32x2){a0, a1};
        }
        __syncthreads();
        float lgc = lg;
        if (MODE == 0) {
#pragma unroll
            for (int q = 0; q < 3; ++q) if (q < sq) { const f32x2 t = *(LAS f32x2*)(TOT + q * 256 + 2 * cp); run0 += t[0]; run1 += t[1]; }
        } else {
            asm volatile("" : "+v"(lgc));
        }
#pragma unroll
        for (int hf = 0; hf < 2; ++hf) {
            unsigned kt0[4], kt1[4];
#pragma unroll
            for (int ii = 0; ii < 8; ii += 2) {
                float ka[2], kb2[2];
#pragma unroll
                for (int d = 0; d < 2; ++d) {
                    const int i = 8 * hf + ii + d, s = 16 * sq + i;
                    float cu0, cu1;
                    if (MODE == 0) { run0 += bflo(ra[i]); run1 += bfhi(ra[i]); cu0 = run0; cu1 = run1; }
                    else { cu0 = lgc * (float)(s + 1); cu1 = cu0; }
                    const float e0 = __expf(cu0), e1 = __expf(cu1), f0 = __expf(-cu0), f1 = __expf(-cu1);
                    *(LAS unsigned*)(lds + QT_OFF + (s * QSTR + 2 * cp) * 2) = pk2(bflo(rq[i]) * e0, bfhi(rq[i]) * e1);
                    ka[d] = bflo(rk[i]) * f0; kb2[d] = bfhi(rk[i]) * f1;
                    *(LAS unsigned*)(lds + KH_OFF + (s * QSTR + 2 * cp) * 2) = pk2(ka[d], kb2[d]);
                    if (MODE == 0 && i == 15 && sq == 3) *(LAS f32x2*)(EV + 2 * cp) = (f32x2){e0, e1};
                }
                kt0[ii >> 1] = pk2(ka[0], ka[1]); kt1[ii >> 1] = pk2(kb2[0], kb2[1]);
            }
            LAS unsigned char* kt = lds + KT_OFF + ((2 * cp) * TSTR + 16 * sq + 8 * hf) * 2;
            *(LAS u32x4*)(kt) = (u32x4){kt0[0], kt0[1], kt0[2], kt0[3]};
            *(LAS u32x4*)(kt + TSTR * 2) = (u32x4){kt1[0], kt1[1], kt1[2], kt1[3]};
        }
        __syncthreads();
        if (item + G < NIT) PRE_LOAD(item + G);
        if (w < 3) {
            const int tb = (w >= 1) ? 1 : 0, sb = (w == 2) ? 1 : 0;
            f32x16 P;
#pragma unroll
            for (int i = 0; i < 16; ++i) P[i] = 0.f;
            const LAS unsigned char* qa = lds + QT_OFF + ((32 * tb + r) * QSTR + 8 * h2) * 2;
            const LAS unsigned char* kb_ = lds + KH_OFF + ((32 * sb + r) * QSTR + 8 * h2) * 2;
#pragma unroll
            for (int st = 0; st < 16; ++st) P = MFMA32(*(const LAS bf16x8*)(qa + st * 32), *(const LAS bf16x8*)(kb_ + st * 32), P);
            LAS bf16_t* pb = (LAS bf16_t*)(lds + PB_OFF);
#pragma unroll
            for (int i = 0; i < 16; ++i) {
                const int tr = crow(i, h2);
                const float pv = (tb == sb && r > tr) ? 0.f : P[i];
                pb[(32 * tb + tr) * TSTR + 32 * sb + r] = (bf16_t)(pk2(pv, 0.f) & 0xffffu);
            }
        }
#pragma unroll
        for (int i = 0; i < 4; ++i) {
            const int f = 4 * w + i, tb = f & 1, st = (f >> 1) & 1, kb = f >> 2;
            const LAS unsigned char* q0 = lds + QT_OFF + ((32 * tb + r) * QSTR + 32 * kb + 16 * st + 4 * h2) * 2;
            const u32x2 lo = *(const LAS u32x2*)(q0), hi = *(const LAS u32x2*)(q0 + 16);
            *(u32x4*)(qseg + (size_t)(2 * f) * (LD * 2) + flo) = (u32x4){lo.x, lo.y, hi.x, hi.y};
        }
#pragma unroll
        for (int i = 0; i < 4; ++i) {
            const int f = 4 * w + i, st = i, kb = w;
            const u32x4 kv = *(const LAS u32x4*)(lds + KT_OFF + ((32 * kb + r) * TSTR + 16 * st + 8 * h2) * 2);
            *(u32x4*)(qseg + KOFF * 2 + (size_t)(2 * f) * (LD * 2) + flo) = kv;
        }
        __syncthreads();
        if (w != 2 && w != 3) {
            const int tb = w >> 2, st = w & 3;
            const u32x4 pv = *(const LAS u32x4*)(lds + PB_OFF + ((32 * tb + r) * TSTR + 16 * st + 8 * h2) * 2);
            if (MODE == 0) *(u32x4*)(qseg + AOFF * 2 + (size_t)(2 * w) * (LD * 2) + flo) = pv;
            else *(u32x4*)(pf_ext + (size_t)item * 8192 + w * 1024 + lane * 16) = pv;
        } else if (MODE == 0 && w == 2) {
            const f32x4 ev = *(const LAS f32x4*)(EV + 4 * lane);
            *(f32x4*)(qseg + AOFF * 2 + (size_t)16 * (LD * 2) + flo) = ev;
        }
    }
#undef PRE_LOAD
#undef PRE_BASE
    __syncthreads();
}

constexpr int QB_OFF = 0, KB_OFF = 32768, VT2_OFF = 98304, EV2_OFF = 116736, XCH_OFF = 118784;
template <int MODE>
__device__ __forceinline__ void scan_phase(LAS unsigned char* lds, bf16_t* proj, const unsigned char* pf_ext, int vcu, int G) {
    constexpr int H = MODE ? 8 : 4, DV = MODE ? 512 : 1024, NSL = DV / 128, LD = MODE ? N1 : N0;
    constexpr int KOFF = MODE ? 2048 : 1024, VOFF = MODE ? 4096 : 2048, AOFF = 10240;
    const int tid = threadIdx.x, lane = tid & 63, w = __builtin_amdgcn_readfirstlane(tid >> 6);
    const int r = lane & 31, h2 = lane >> 5, vb = w & 3, kh = w >> 2;
    const int vp = lane, s8 = w;
    LAS float* XCH = (LAS float*)(lds + XCH_OFF);
    const unsigned flo = (unsigned)h2 * (LD * 2) + r * 16;
    const unsigned vlo = ((unsigned)(8 * s8) * LD + 2 * vp) * 2u;
    for (int item = vcu; item < 256; item += G) {
        const int vs = item % NSL, hh = (item / NSL) % H, b = item / (NSL * H);
        const size_t rowb = (size_t)b * SEQ;
        const char* qseg0 = (const char*)(proj + rowb * LD + hh * 256);
        bf16_t* vbase = proj + rowb * LD + VOFF + hh * DV + vs * 128;
        const unsigned char* pfb = pf_ext + (size_t)((b * H + hh) * 64) * 8192;
        const float gdec = MODE ? __expf(64.0f * log1pf(-exp2f(-5.0f - (float)hh))) : 1.0f;
        f32x16 S[4];
#pragma unroll
        for (int j = 0; j < 4; ++j)
#pragma unroll
            for (int i = 0; i < 16; ++i) S[j][i] = 0.f;
        unsigned rv[8]; u32x4 pf[4]; f32x16 oprev;
#define SC_SEG(c) (qseg0 + (size_t)((c) * 64) * (LD * 2))
#define SC_DMA(c) do { const char* _s = SC_SEG(c); const int _b = (c) & 1; \
            _Pragma("unroll") for (int i = 0; i < 4; ++i) __builtin_amdgcn_global_load_lds((const unsigned*)(_s + KOFF * 2 + (size_t)(2 * (4 * w + i)) * (LD * 2) + flo), (LAS unsigned*)(lds + KB_OFF + _b * 32768 + (4 * w + i) * 1024), 16, 0, 0); \
            _Pragma("unroll") for (int i = 0; i < 4; ++i) __builtin_amdgcn_global_load_lds((const unsigned*)(_s + (size_t)(2 * (4 * w + i)) * (LD * 2) + flo), (LAS unsigned*)(lds + QB_OFF + (4 * w + i) * 1024), 16, 0, 0); \
            if (MODE == 0 && w == 0) __builtin_amdgcn_global_load_lds((const unsigned*)(_s + AOFF * 2 + (size_t)16 * (LD * 2) + flo), (LAS unsigned*)(lds + EV2_OFF + _b * 1024), 16, 0, 0); } while (0)
#define SC_LOADV(c) do { const char* _v = (const char*)(vbase + (size_t)((c) * 64) * LD); \
            _Pragma("unroll") for (int i = 0; i < 8; ++i) rv[i] = __builtin_nontemporal_load((const unsigned*)(_v + (size_t)i * (LD * 2) + vlo)); } while (0)
#define SC_LOADP(c) do { _Pragma("unroll") for (int st = 0; st < 4; ++st) if (st < 2 || kh) { \
            if (MODE == 0) pf[st] = *(const u32x4*)(SC_SEG(c) + AOFF * 2 + (size_t)(2 * (4 * kh + st)) * (LD * 2) + flo); \
            else pf[st] = *(const u32x4*)(pfb + (size_t)(c) * 8192 + (4 * kh + st) * 1024 + lane * 16); } } while (0)
        SC_DMA(0); SC_LOADV(0); SC_LOADP(0);
        for (int c = 0; c < 64; ++c) {
            {
                u32x4 v0, v1;
                v0.x = (rv[0] & 0xffffu) | (rv[1] << 16); v0.y = (rv[2] & 0xffffu) | (rv[3] << 16); v0.z = (rv[4] & 0xffffu) | (rv[5] << 16); v0.w = (rv[6] & 0xffffu) | (rv[7] << 16);
                v1.x = (rv[0] >> 16) | (rv[1] & 0xffff0000u); v1.y = (rv[2] >> 16) | (rv[3] & 0xffff0000u); v1.z = (rv[4] >> 16) | (rv[5] & 0xffff0000u); v1.w = (rv[6] >> 16) | (rv[7] & 0xffff0000u);
                LAS unsigned char* vt = lds + VT2_OFF + ((2 * vp) * TSTR + 8 * s8) * 2;
                *(LAS u32x4*)(vt) = v0; *(LAS u32x4*)(vt + TSTR * 2) = v1;
            }
            asm volatile("s_waitcnt vmcnt(0)" ::: "memory");
            __syncthreads();
            if (c > 0) {
                char* op = (char*)(vbase + (size_t)((c - 1) * 64 + 32 * kh) * LD);
                const unsigned olo = ((unsigned)(4 * h2) * LD + 32 * vb + r) * 2u;
#pragma unroll
                for (int i = 0; i < 16; ++i) __builtin_nontemporal_store((bf16_t)(pk2(oprev[i], 0.f) & 0xffffu), (bf16_t*)(op + (size_t)((i & 3) + 8 * (i >> 2)) * (LD * 2) + olo));
            }
            if (c + 1 < 64) SC_LOADV(c + 1);
            f32x16 op0, op1;
#pragma unroll
            for (int i = 0; i < 16; ++i) { op0[i] = 0.f; op1[i] = 0.f; }
#pragma unroll
            for (int j = 0; j < 4; ++j) {
#pragma unroll
                for (int st = 0; st < 2; ++st) {
                    u32x4 sp; sp.x = pk2(S[j][8 * st + 0], S[j][8 * st + 1]); sp.y = pk2(S[j][8 * st + 2], S[j][8 * st + 3]); sp.z = pk2(S[j][8 * st + 4], S[j][8 * st + 5]); sp.w = pk2(S[j][8 * st + 6], S[j][8 * st + 7]);
                    const bf16x8 sfrag = __builtin_bit_cast(bf16x8, sp);
                    const LAS unsigned char* qf = lds + QB_OFF + ((((4 * kh + j) * 2 + st) * 2) * 1024) + lane * 16;
                    op0 = MFMA32(*(const LAS bf16x8*)(qf), sfrag, op0);
                    op1 = MFMA32(*(const LAS bf16x8*)(qf + 1024), sfrag, op1);
                }
            }
            __syncthreads();
            if (c + 1 < 64) SC_DMA(c + 1);
            f32x16 o;
#pragma unroll
            for (int i = 0; i < 16; ++i) { XCH[w * 1024 + i * 64 + lane] = kh ? op0[i] : op1[i]; o[i] = kh ? op1[i] : op0[i]; }
            bf16x8 vf[4];
#pragma unroll
            for (int st = 0; st < 4; ++st) vf[st] = *(const LAS bf16x8*)(lds + VT2_OFF + ((32 * vb + r) * TSTR + 16 * st + 8 * h2) * 2);
            o = MFMA32(__builtin_bit_cast(bf16x8, pf[0]), vf[0], o);
            o = MFMA32(__builtin_bit_cast(bf16x8, pf[1]), vf[1], o);
            if (kh) { o = MFMA32(__builtin_bit_cast(bf16x8, pf[2]), vf[2], o); o = MFMA32(__builtin_bit_cast(bf16x8, pf[3]), vf[3], o); }
            if (c + 1 < 64) SC_LOADP(c + 1);
            const LAS unsigned char* kfb = lds + KB_OFF + (c & 1) * 32768 + lane * 16;
            const LAS float* EVc = (const LAS float*)(lds + EV2_OFF + (c & 1) * 1024);
#pragma unroll
            for (int j = 0; j < 4; ++j) {
                const int kb = 4 * kh + j;
#pragma unroll
                for (int st = 0; st < 4; ++st) S[j] = MFMA32(*(const LAS bf16x8*)(kfb + (kb * 4 + st) * 1024), vf[st], S[j]);
                if (MODE == 0) {
#pragma unroll
                    for (int g4 = 0; g4 < 4; ++g4) { const f32x4 e = *(const LAS f32x4*)(EVc + 32 * kb + 8 * g4 + 4 * h2);
#pragma unroll
                        for (int q = 0; q < 4; ++q) S[j][4 * g4 + q] *= e[q]; }
                } else {
#pragma unroll
                    for (int i = 0; i < 16; ++i) S[j][i] *= gdec;
                }
            }
            __syncthreads();
#pragma unroll
            for (int i = 0; i < 16; ++i) oprev[i] = o[i] + XCH[(w ^ 4) * 1024 + i * 64 + lane];
        }
        {
            char* op = (char*)(vbase + (size_t)(63 * 64 + 32 * kh) * LD);
            const unsigned olo = ((unsigned)(4 * h2) * LD + 32 * vb + r) * 2u;
#pragma unroll
            for (int i = 0; i < 16; ++i) __builtin_nontemporal_store((bf16_t)(pk2(oprev[i], 0.f) & 0xffffu), (bf16_t*)(op + (size_t)((i & 3) + 8 * (i >> 2)) * (LD * 2) + olo));
        }
#undef SC_SEG
#undef SC_DMA
#undef SC_LOADV
#undef SC_LOADP
        asm volatile("s_waitcnt vmcnt(0)" ::: "memory");
        __syncthreads();
    }
}

template <int MODE>
__device__ __forceinline__ void ew_phase(bf16_t* proj, const float* gain, const float* bias, int gw, int NGW, int lane) {
    constexpr int H = MODE ? 8 : 4, DV = MODE ? 512 : 1024, LD = MODE ? N1 : N0, NC = DV / 512;
    constexpr int VOFF = MODE ? 4096 : 2048, GOFF = VOFF + DI;
    for (int p = gw; p < T * H; p += NGW) {
        const int t = p / H, hh = p % H;
        bf16_t* orow = proj + (size_t)t * LD + VOFF + hh * DV;
        const bf16_t* grow = proj + (size_t)t * LD + GOFF + hh * DV;
        u32x4 ov[NC], gv[NC];
#pragma unroll
        for (int cc = 0; cc < NC; ++cc) { ov[cc] = __builtin_nontemporal_load((const u32x4*)(orow + cc * 512 + lane * 8)); gv[cc] = __builtin_nontemporal_load((const u32x4*)(grow + cc * 512 + lane * 8)); }
        float s1 = 0.f, s2 = 0.f;
#pragma unroll
        for (int cc = 0; cc < NC; ++cc)
#pragma unroll
            for (int q = 0; q < 4; ++q) { const float oa = bflo(ov[cc][q]), ob = bfhi(ov[cc][q]); s1 += oa + ob; s2 += oa * oa + ob * ob; }
        s1 = wave_sum(s1); s2 = wave_sum(s2);
        float mu = 0.f, rs;
        if (MODE == 0) rs = rsqrtf(s2 * (1.0f / DV) + EPS);
        else { mu = s1 * (1.0f / DV); rs = rsqrtf(fmaxf(s2 * (1.0f / DV) - mu * mu, 0.f) + EPS); }
#pragma unroll
        for (int cc = 0; cc < NC; ++cc) {
            const int col = cc * 512 + lane * 8;
            const f32x4 g0 = *(const f32x4*)(gain + hh * DV + col), g1 = *(const f32x4*)(gain + hh * DV + col + 4);
            f32x4 b0 = (f32x4){0.f, 0.f, 0.f, 0.f}, b1 = b0;
            if (MODE == 1) { b0 = *(const f32x4*)(bias + hh * DV + col); b1 = *(const f32x4*)(bias + hh * DV + col + 4); }
            const float gg[8] = {g0[0], g0[1], g0[2], g0[3], g1[0], g1[1], g1[2], g1[3]}, bb[8] = {b0[0], b0[1], b0[2], b0[3], b1[0], b1[1], b1[2], b1[3]};
            u32x4 res;
#pragma unroll
            for (int q = 0; q < 4; ++q) {
                const float oa = bflo(ov[cc][q]), ob = bfhi(ov[cc][q]), ga = bflo(gv[cc][q]), gb = bfhi(gv[cc][q]);
                const float ya = ((oa - mu) * rs * gg[2 * q] + bb[2 * q]) * (ga / (1.0f + __expf(-ga)));
                const float yb = ((ob - mu) * rs * gg[2 * q + 1] + bb[2 * q + 1]) * (gb / (1.0f + __expf(-gb)));
                res[q] = pk2(ya, yb);
            }
            *(u32x4*)(orow + col) = res;
        }
    }
}

__device__ __forceinline__ void p0_transpose_item(const float* W, int K, int N, bf16_t* WT, int row_off, LAS float* scr, int item, int lane, const float* kvec, int sc0, int sc1, float sc) {
    const int nblk = N / 32, kb = item / nblk, nb = item % nblk, k0 = 64 * kb, n0 = 32 * nb;
    const float cs = (n0 >= sc0 && n0 < sc1) ? sc : 1.0f;
#pragma unroll 8
    for (int i = 0; i < 32; ++i) { const int kk = 2 * i + (lane >> 5); const float kv = kvec ? kvec[k0 + kk] : 1.0f; scr[kk * 33 + (lane & 31)] = __builtin_nontemporal_load(W + (size_t)(k0 + kk) * N + n0 + (lane & 31)) * (kv * cs); }
    asm volatile("s_waitcnt lgkmcnt(0)" ::: "memory");
    const int c = lane & 7;
#pragma unroll
    for (int j = 0; j < 4; ++j) { const int n = (lane >> 3) + 8 * j; const LAS float* s = scr + (8 * c) * 33 + n;
        u32x4 o; o.x = pk2(s[0 * 33], s[1 * 33]); o.y = pk2(s[2 * 33], s[3 * 33]); o.z = pk2(s[4 * 33], s[5 * 33]); o.w = pk2(s[6 * 33], s[7 * 33]);
        *(u32x4*)(WT + (size_t)(row_off + n0 + n) * K + k0 + 8 * c) = o; }
    asm volatile("s_waitcnt lgkmcnt(0)" ::: "memory");
}

#define XB_TMO      128
#define XB_XCNT(j)  (256  + 64 * (j))
#define XB_XSUB(j)  (1280 + 64 * (j))
#define XB_XGEN(j)  (2304 + 64 * (j))
#define XB_TOP      3328
#define XB_TOPGEN   3392
#define XCD_BAR_WORDS 3456
#define XB_SPIN_CAP (1u << 18)

__device__ __forceinline__ unsigned xb_ld(unsigned* p)              { return __hip_atomic_load(p, __ATOMIC_RELAXED, __HIP_MEMORY_SCOPE_AGENT); }
__device__ __forceinline__ unsigned xb_add(unsigned* p, unsigned v) { return __hip_atomic_fetch_add(p, v, __ATOMIC_RELAXED, __HIP_MEMORY_SCOPE_AGENT); }
__device__ __forceinline__ unsigned xb_xcc_id() { return (unsigned)__builtin_amdgcn_s_getreg((3 << 11) | 20) & 0xFu; }
#define XB_SPIN(cond, bar) do { unsigned _sp = 0; while (cond) { __builtin_amdgcn_s_sleep(1); \
    if ((++_sp & 255u) == 0u) { if (xb_ld(&(bar)[XB_TMO])) break; if (_sp > XB_SPIN_CAP) { atomicAdd(&(bar)[XB_TMO], 1u); break; } } } } while (0)

struct XcdBarrier {
    unsigned* bar; unsigned x;
    volatile LAS unsigned* st;
};

__device__ __forceinline__ XcdBarrier xcd_barrier_post(unsigned* bar, volatile LAS unsigned* st) {
    XcdBarrier b; b.bar = bar; b.x = xb_xcc_id(); b.st = st;
    if (threadIdx.x == 0) st[2] = xb_add(&bar[XB_XCNT(b.x)], 1u);
    return b;
}
__device__ __forceinline__ void xcd_barrier_complete(unsigned* bar, unsigned x, unsigned& nloc, unsigned& nx) {
    const unsigned G = gridDim.x * gridDim.y * gridDim.z;
    unsigned sum, cnt, mine, sp = 0u;
    for (;;) {
        sum = 0u; cnt = 0u; mine = 0u;
#pragma unroll
        for (unsigned j = 0; j < 16; ++j) { const unsigned c = xb_ld(&bar[XB_XCNT(j)]); sum += c; cnt += (c > 0u) ? 1u : 0u; mine = (j == x) ? c : mine; }
        if (sum == G) break;
        __builtin_amdgcn_s_sleep(1);
        if ((++sp & 255u) == 0u) { if (xb_ld(&bar[XB_TMO])) break; if (sp > XB_SPIN_CAP) { atomicAdd(&bar[XB_TMO], 1u); break; } }
    }
    nloc = mine > 0u ? mine : 1u; nx = cnt > 0u ? cnt : 1u;
}

__device__ __forceinline__ void xcd_barrier(const XcdBarrier& b) {
    asm volatile("s_waitcnt vmcnt(0)" ::: "memory");
    __syncthreads();
    if (threadIdx.x == 0) {
        unsigned* bar = b.bar;
        __builtin_amdgcn_s_waitcnt(0);
        unsigned nloc = b.st[0], nx = b.st[1];
        if (nloc == 0u) { xcd_barrier_complete(bar, b.x, nloc, nx); b.st[0] = nloc; b.st[1] = nx; }
        const unsigned old = xb_add(&bar[XB_XSUB(b.x)], 1u);
        const unsigned gen = old / nloc;
        if (old + 1u == (gen + 1u) * nloc) {
            __builtin_amdgcn_fence(__ATOMIC_RELEASE, "agent");
            asm volatile("s_waitcnt vmcnt(0)" ::: "memory");
            const unsigned og = xb_add(&bar[XB_TOP], 1u);
            const unsigned tg = og / nx;
            if (og + 1u == (tg + 1u) * nx) xb_add(&bar[XB_TOPGEN], 1u);
            else XB_SPIN(xb_ld(&bar[XB_TOPGEN]) == tg, bar);
            __builtin_amdgcn_fence(__ATOMIC_ACQUIRE, "agent");
            xb_add(&bar[XB_XGEN(b.x)], 1u);
            asm volatile("s_waitcnt vmcnt(0)" ::: "memory");
        } else {
            XB_SPIN(xb_ld(&bar[XB_XGEN(b.x)]) == gen, bar);
            __builtin_amdgcn_fence(__ATOMIC_ACQUIRE, "agent");
            asm volatile("s_waitcnt vmcnt(0)" ::: "memory");
        }
    }
    __syncthreads();
}

struct Args {
    const float* x; const int* pos;
    const float *gla_norm, *gla_w_in, *gla_w_a1, *gla_w_a2, *gla_b_a, *gla_head_g, *gla_w_out;
    const float *ret_norm, *ret_w_in, *ret_gn_g, *ret_gn_b, *ret_w_out, *final_norm;
    float* out; unsigned char* ws;
};

__global__ void __launch_bounds__(512, 2) fwd(Args a) {
    extern __shared__ __attribute__((aligned(16))) unsigned char lds_raw[];
    LAS unsigned char* lds = (LAS unsigned char*)lds_raw;
    cg::grid_group grid = cg::this_grid();
    const int tid = threadIdx.x, lane = tid & 63, wave = __builtin_amdgcn_readfirstlane(tid >> 6);
    const int G = gridDim.x, bx = blockIdx.x;
    const int vcu = (G % 8 == 0) ? (bx % 8) * (G / 8) + bx / 8 : bx;
    const int gw = vcu * 8 + wave, NGW = G * 8;
    const int gtid = bx * 512 + tid, NGT = G * 512;
    unsigned char* ws = a.ws;
    if (tid < 4) ((LAS unsigned*)(lds + LDS_BARW))[tid] = 0u;
    __syncthreads();
    XcdBarrier xbar = xcd_barrier_post((unsigned*)(ws + WS_BAR), (volatile LAS unsigned*)(lds + LDS_BARW));
    bf16_t* W0T = (bf16_t*)(ws + WS_W0T); bf16_t* WOUT0T = (bf16_t*)(ws + WS_WOUT0T); bf16_t* W1T = (bf16_t*)(ws + WS_W1T); bf16_t* WOUT1T = (bf16_t*)(ws + WS_WOUT1T);
    bf16_t* H1BF = (bf16_t*)(ws + WS_H1BF); bf16_t* PROJ = (bf16_t*)(ws + WS_PROJ);
    bf16_t* HN = (bf16_t*)a.out;
    f32x2* ROT = (f32x2*)(ws + WS_ROT); float* SUMSQ1 = (float*)(ws + WS_SUMSQ1);

#ifdef PROBE_A
    unsigned long long* TS = (unsigned long long*)(ws + 60 * MiB);
    int nst = 0;
#define STAMP() do { if (bx == 0 && tid == 0) TS[nst] = __builtin_amdgcn_s_memrealtime(); ++nst; } while (0)
#else
#define STAMP() do {} while (0)
#endif
    STAMP();
    {
        LAS float* scr = (LAS float*)(lds + wave * 8704);
        constexpr int I_W0 = (D / 64) * (10240 / 32), I_WO = (DI / 64) * (D / 32), I_W1 = (D / 64) * (N1 / 32);
        constexpr int NITEMS = I_W0 + I_WO + I_W1 + I_WO;
        for (int it = gw; it < NITEMS; it += NGW) {
            int q = it;
            if (q < I_W0) { p0_transpose_item(a.gla_w_in, D, 10240, W0T, 0, scr, q, lane, nullptr, 0, 1024, 0.0625f); continue; } q -= I_W0;
            if (q < I_WO) { p0_transpose_item(a.gla_w_out, DI, D, WOUT0T, 0, scr, q, lane, nullptr, 0, 0, 1.0f); continue; } q -= I_WO;
            if (q < I_W1) { p0_transpose_item(a.ret_w_in, D, N1, W1T, 0, scr, q, lane, a.ret_norm, 2048, 4096, 0.0625f); continue; } q -= I_W1;
            p0_transpose_item(a.ret_w_out, DI, D, WOUT1T, 0, scr, q, lane, nullptr, 0, 0, 1.0f);
        }
        for (int idx = gtid; idx < 1024 * 256; idx += NGT) {
            const int n = idx >> 8, kc = idx & 255;
            float a2[16];
#pragma unroll
            for (int rr = 0; rr < 16; ++rr) a2[rr] = a.gla_w_a2[rr * 1024 + n];
            float res[8];
#pragma unroll
            for (int kk = 0; kk < 8; ++kk) {
                const f32x4* p = (const f32x4*)(a.gla_w_a1 + (size_t)(8 * kc + kk) * 16);
                const f32x4 p0 = p[0], p1 = p[1], p2 = p[2], p3 = p[3];
                res[kk] = p0[0] * a2[0] + p0[1] * a2[1] + p0[2] * a2[2] + p0[3] * a2[3] + p1[0] * a2[4] + p1[1] * a2[5] + p1[2] * a2[6] + p1[3] * a2[7]
                        + p2[0] * a2[8] + p2[1] * a2[9] + p2[2] * a2[10] + p2[3] * a2[11] + p3[0] * a2[12] + p3[1] * a2[13] + p3[2] * a2[14] + p3[3] * a2[15];
            }
            *(u32x4*)(W0T + (size_t)(10240 + n) * D + 8 * kc) = (u32x4){pk2(res[0], res[1]), pk2(res[2], res[3]), pk2(res[4], res[5]), pk2(res[6], res[7])};
        }
        for (int m = gw; m < T; m += NGW) {
            const f32x4* xr = (const f32x4*)(a.x + (size_t)m * D) + lane;
            const f32x4* gr = (const f32x4*)a.gla_norm + lane;
            f32x4 v[8]; float s = 0.f;
#pragma unroll
            for (int j = 0; j < 8; ++j) { v[j] = __builtin_nontemporal_load(xr + 64 * j); s += (v[j][0] * v[j][0] + v[j][1] * v[j][1]) + (v[j][2] * v[j][2] + v[j][3] * v[j][3]); }
            const float rs = rsqrtf(wave_sum(s) * (1.0f / D) + EPS);
            u32x2* o8 = (u32x2*)(HN + (size_t)m * D) + lane;
#pragma unroll
            for (int j = 0; j < 8; ++j) { const f32x4 g = gr[64 * j]; o8[64 * j] = (u32x2){pk2(v[j][0] * rs * g[0], v[j][1] * rs * g[1]), pk2(v[j][2] * rs * g[2], v[j][3] * rs * g[3])}; }
        }
    }
    if (a.ws == nullptr) grid.sync();
    xcd_barrier(xbar); STAMP();
    int pcu;
    {
        volatile LAS unsigned* bst = (volatile LAS unsigned*)(lds + LDS_BARW);
        if (tid == 0) {
            const unsigned* bw = (const unsigned*)(ws + WS_BAR);
            unsigned base = 0u;
            for (unsigned j = 0; j < 16; ++j) { const unsigned cj = __hip_atomic_load(bw + XB_XCNT(j), __ATOMIC_RELAXED, __HIP_MEMORY_SCOPE_AGENT); if (j < xbar.x) base += cj; }
            bst[3] = base + bst[2];
        }
        __syncthreads();
        pcu = (int)bst[3];
        if (pcu < 0 || pcu >= G) pcu = vcu;
    }
    const int gw2 = pcu * 8 + wave;
    {
        pg8::Gemm g{HN, W0T, T, N0, D, D}; pg8::StaticOrder S; S.init(T, N0, G, bx);
        pg8::EpiProj E{PROJ, N0, 0, nullptr, a.gla_b_a, nullptr};
        pg8::gemm_phase<pg8::EpiProj>(lds, g, S, E);
    }
    xcd_barrier(xbar); STAMP();
    prescan_phase<0>(lds, PROJ, nullptr, pcu, G);
    xcd_barrier(xbar); STAMP();
    scan_phase<0>(lds, PROJ, nullptr, pcu, G);
    xcd_barrier(xbar); STAMP();
    {
        ew_phase<0>(PROJ, a.gla_head_g, nullptr, gw2, NGW, lane);
        for (int idx = gtid; idx < T * 128; idx += NGT) {
            const int t = idx >> 7, i = idx & 127;
            const double invf = exp(-(double)i * (9.210340371976184 / 128.0));
            const double ang = (double)a.pos[t] * invf;
            double rev = ang * 0.15915494309189535; rev -= floor(rev);
            const float fr = (float)rev;
            ROT[idx] = (f32x2){__builtin_amdgcn_cosf(fr), __builtin_amdgcn_sinf(fr)};
        }
        for (int idx = gtid; idx < T; idx += NGT) SUMSQ1[idx] = 0.f;
    }
    xcd_barrier(xbar); STAMP();
    {
        pg8::Gemm g{PROJ + 2048, WOUT0T, T, D, DI, N0}; pg8::StaticOrder S; S.init(T, D, G, bx);
        pg8::EpiOut E{a.x, nullptr, H1BF, SUMSQ1};
        pg8::gemm_phase<pg8::EpiOut>(lds, g, S, E);
    }
    xcd_barrier(xbar); STAMP();
    {
        pg8::Gemm g{H1BF, W1T, T, N1, D, D}; pg8::StaticOrder S; S.init(T, N1, G, bx);
        pg8::EpiProj E{PROJ, N1, 1, SUMSQ1, nullptr, ROT};
        pg8::gemm_phase<pg8::EpiProj>(lds, g, S, E);
    }
    xcd_barrier(xbar); STAMP();
    prescan_phase<1>(lds, PROJ, ws + WS_ROT, pcu, G);
    xcd_barrier(xbar); STAMP();
    scan_phase<1>(lds, PROJ, ws + WS_ROT, pcu, G);
    xcd_barrier(xbar); STAMP();
    ew_phase<1>(PROJ, a.ret_gn_g, a.ret_gn_b, gw2, NGW, lane);
    xcd_barrier(xbar); STAMP();
    {
        pg8::Gemm g{PROJ + 4096, WOUT1T, T, D, DI, N1}; pg8::StaticOrder S; S.init(T, D, G, bx);
        pg8::EpiOut E{nullptr, H1BF, H1BF, nullptr};
        pg8::gemm_phase<pg8::EpiOut>(lds, g, S, E);
    }
    xcd_barrier(xbar); STAMP();
    for (int m = gw2; m < T; m += NGW) {
        const u32x4* hr = (const u32x4*)(H1BF + (size_t)m * D) + lane;
        u32x4 hv[4]; float s = 0.f;
#pragma unroll
        for (int j = 0; j < 4; ++j) { hv[j] = __builtin_nontemporal_load(hr + 64 * j);
#pragma unroll
            for (int q = 0; q < 4; ++q) { const float lo = bflo(hv[j][q]), hi = bfhi(hv[j][q]); s += lo * lo + hi * hi; } }
        const float rs = rsqrtf(wave_sum(s) * (1.0f / D) + EPS);
#pragma unroll
        for (int j = 0; j < 4; ++j) {
            const int col = 512 * j + 8 * lane;
            const f32x4 g0 = *(const f32x4*)(a.final_norm + col), g1 = *(const f32x4*)(a.final_norm + col + 4);
            f32x4 y0 = (f32x4){bflo(hv[j][0]), bfhi(hv[j][0]), bflo(hv[j][1]), bfhi(hv[j][1])} * rs * g0;
            f32x4 y1 = (f32x4){bflo(hv[j][2]), bfhi(hv[j][2]), bflo(hv[j][3]), bfhi(hv[j][3])} * rs * g1;
            __builtin_nontemporal_store(y0, (f32x4*)(a.out + (size_t)m * D + col)); __builtin_nontemporal_store(y1, (f32x4*)(a.out + (size_t)m * D + col + 4));
        }
    }
}

extern "C" void kernel_launch(void* const* d_in, const int* in_sizes, int n_in, void* d_out, int out_size, void* d_ws, size_t ws_size, hipStream_t stream) {
    static int grid = 0;
    if (grid == 0) {
        int dev = 0, cus = 0, per_cu = 0;
        (void)hipGetDevice(&dev);
        (void)hipDeviceGetAttribute(&cus, hipDeviceAttributeMultiprocessorCount, dev);
        (void)hipFuncSetAttribute((const void*)fwd, hipFuncAttributeMaxDynamicSharedMemorySize, LDS_BYTES);
        (void)hipOccupancyMaxActiveBlocksPerMultiprocessor(&per_cu, (const void*)fwd, 512, LDS_BYTES);
        if (per_cu < 1) per_cu = 1;
        grid = cus * per_cu;
        if (ws_size < 1024 * MiB) fprintf(stderr, "kernel_launch: workspace too small (%zu)\n", ws_size);
    }
    Args a{};
    a.x = (const float*)d_in[0]; a.pos = (const int*)d_in[1];
    a.gla_norm = (const float*)d_in[2]; a.gla_w_in = (const float*)d_in[3]; a.gla_w_a1 = (const float*)d_in[4]; a.gla_w_a2 = (const float*)d_in[5];
    a.gla_b_a = (const float*)d_in[6]; a.gla_head_g = (const float*)d_in[7]; a.gla_w_out = (const float*)d_in[8];
    a.ret_norm = (const float*)d_in[9]; a.ret_w_in = (const float*)d_in[10]; a.ret_gn_g = (const float*)d_in[11]; a.ret_gn_b = (const float*)d_in[12];
    a.ret_w_out = (const float*)d_in[13]; a.final_norm = (const float*)d_in[14];
    a.out = (float*)d_out; a.ws = (unsigned char*)d_ws;
    (void)hipMemsetAsync((char*)d_ws + WS_BAR, 0, WS_BAR_BYTES, stream);
    void* args[] = {&a};
    hipError_t e = hipLaunchCooperativeKernel((const void*)fwd, dim3(grid), dim3(512), args, LDS_BYTES, stream);
    if (e != hipSuccess) fprintf(stderr, "cooperative launch failed: %s (grid %d)\n", hipGetErrorString(e), grid);
}
```

```cpp
#include <hip/hip_runtime.h>
#include <hip/hip_cooperative_groups.h>
#include <cstdio>
#include <cstdint>
namespace cg = cooperative_groups;

#define LAS __attribute__((address_space(3)))
typedef unsigned short bf16_t;
typedef short bf16x8 __attribute__((ext_vector_type(8)));
typedef short s16x4 __attribute__((ext_vector_type(4)));
typedef float f32x4 __attribute__((ext_vector_type(4)));
typedef float f32x2 __attribute__((ext_vector_type(2)));
typedef float f32x16 __attribute__((ext_vector_type(16)));
typedef unsigned u32x4 __attribute__((ext_vector_type(4)));
typedef unsigned u32x2 __attribute__((ext_vector_type(2)));
typedef __bf16 bf2_t __attribute__((ext_vector_type(2)));

constexpr int T = 32768, D = 2048, DI = 4096, SEQ = 4096;
constexpr int N0 = 11264, N1 = 12288, N0G = 10496;
constexpr float EPS = 1e-6f;
constexpr size_t MiB = 1u << 20;
constexpr size_t WS_W0T = 0, WS_WOUT0T = 44 * MiB, WS_W1T = 64 * MiB, WS_WOUT1T = 112 * MiB, WS_H1BF = 128 * MiB, WS_PROJ = 256 * MiB;
constexpr size_t WS_ROT = 0, WS_SUMSQ1 = 32 * MiB;
constexpr int LDS_BYTES = 155648, LDS_BARW = 155584;
constexpr size_t WS_BAR = 60 * MiB, WS_BAR_BYTES = 16384;

__device__ __forceinline__ unsigned pk2(float lo, float hi) { bf2_t r = __builtin_convertvector((f32x2){lo, hi}, bf2_t); return __builtin_bit_cast(unsigned, r); }
__device__ __forceinline__ float bflo(unsigned u) { return __builtin_bit_cast(float, u << 16); }
__device__ __forceinline__ float bfhi(unsigned u) { return __builtin_bit_cast(float, u & 0xffff0000u); }
__device__ __forceinline__ float wave_sum(float v) {
#pragma unroll
    for (int o = 1; o < 64; o <<= 1) v += __shfl_xor(v, o);
    return v;
}

namespace pg8 {
constexpr int BM = 256, BK = 64, HALF = 128, HTB = HALF * BK * 2, STAGE_BYTES = 8 * HTB, NXCD = 8, WGM = 8;
__host__ __device__ __forceinline__ int lds_byte(int r, int c) { const int st = (r >> 4) * 2 + (c >> 5), rr = r & 15, cc = c & 31, ob = rr * 64 + cc * 2; return st * 1024 + (ob ^ (((ob >> 9) & 1) << 5)); }
__host__ __device__ __forceinline__ void stage_rc(int b, int& R, int& C) { const int st = b / 1024, sb = b % 1024, swz = sb ^ (((sb >> 9) & 1) << 5); R = (st >> 1) * 16 + swz / 64; C = (st & 1) * 32 + (swz % 64) / 2; }
__host__ __device__ __forceinline__ int perm32(int rho) { const int n = rho >> 4, i = rho & 15; return 8 * (i >> 2) + 4 * n + (i & 3); }

struct Unit { int pm, pn; };
struct Gemm { const bf16_t* A; const bf16_t* Bt; int M, N, K, lda; };

struct StaticOrder {
    int nM, nN, nwg, G, c;
    __device__ void init(int M, int N, int G_, int c_) { nM = M / BM; nN = N / BM; nwg = nM * nN; G = G_; c = c_; }
    __device__ bool next(int i, Unit& u) const {
        const long L = (long)i * G + c; if (L >= nwg) return false;
        int wgid = (int)L; { const int q = nwg / NXCD, r = nwg % NXCD, xcd = wgid % NXCD, off = wgid / NXCD; wgid = (xcd < r ? xcd * (q + 1) : r * (q + 1) + (xcd - r) * q) + off; }
        const int nig = WGM * nN, gid = wgid / nig, fm = gid * WGM, gsz = (nM - fm) < WGM ? (nM - fm) : WGM;
        u.pm = fm + ((wgid % nig) % gsz); u.pn = (wgid % nig) / gsz; return true;
    }
};


struct EpiProj {
    static constexpr bool PERM = true;
    bf16_t* O; int ldc; int mode;
    const float* rowsumsq;
    float* ubuf;
    const f32x2* rot;
    __device__ __forceinline__ void operator()(const f32x4 (&acc)[2][2][4][2], const Unit& u, int wr, int wc, int fr, int fq) const {
        const int row0 = u.pm * BM + wr * 64 + fr, col0 = u.pn * BM + wc * 32 + 8 * fq;
        if (mode == 0 && u.pn == 40) {
            if (wc == 0 && fq < 2) {
#pragma unroll
                for (int ai = 0; ai < 2; ++ai)
#pragma unroll
                    for (int m = 0; m < 4; ++m) { float* up = ubuf + (size_t)(row0 + ai * HALF + m * 16) * 16 + 8 * fq;
                        *(f32x4*)(up) = acc[ai][0][m][0]; *(f32x4*)(up + 4) = acc[ai][0][m][1]; }
            }
            return;
        }
        const bool is_rot = (mode == 1) && (u.pn < 16);
#pragma unroll
        for (int ai = 0; ai < 2; ++ai)
#pragma unroll
            for (int m = 0; m < 4; ++m) {
                const int row = row0 + ai * HALF + m * 16;
                const float rs = rowsumsq ? rsqrtf(rowsumsq[row] * (1.0f / D) + EPS) : 1.0f;
                f32x4 v[2][2];
#pragma unroll
                for (int bj = 0; bj < 2; ++bj)
#pragma unroll
                    for (int n = 0; n < 2; ++n) v[bj][n] = acc[ai][bj][m][n] * rs;
                if (is_rot) {
                    const f32x2* rp = rot + (size_t)row * 128 + wc * 32 + 8 * fq;
#pragma unroll
                    for (int n = 0; n < 2; ++n) {
                        const f32x4 t0 = *(const f32x4*)(rp + 4 * n), t1 = *(const f32x4*)(rp + 4 * n + 2);
                        const float cs[4] = {t0[0], t0[2], t1[0], t1[2]}, sn[4] = {t0[1], t0[3], t1[1], t1[3]};
#pragma unroll
                        for (int j = 0; j < 4; ++j) { const float x1 = v[0][n][j], x2 = v[1][n][j]; v[0][n][j] = x1 * cs[j] - x2 * sn[j]; v[1][n][j] = x2 * cs[j] + x1 * sn[j]; }
                    }
                }
                bf16_t* rowp = O + (size_t)row * ldc + col0;
#pragma unroll
                for (int bj = 0; bj < 2; ++bj) {
                    u32x4 w; w.x = pk2(v[bj][0][0], v[bj][0][1]); w.y = pk2(v[bj][0][2], v[bj][0][3]); w.z = pk2(v[bj][1][0], v[bj][1][1]); w.w = pk2(v[bj][1][2], v[bj][1][3]);
                    *(u32x4*)(rowp + bj * HALF) = w;
                }
            }
    }
};
struct EpiOut {
    static constexpr bool PERM = true;
    const float* resid32; const bf16_t* resid16; bf16_t* out16; float* sumsq;
    __device__ __forceinline__ void operator()(const f32x4 (&acc)[2][2][4][2], const Unit& u, int wr, int wc, int fr, int fq) const {
        const int row0 = u.pm * BM + wr * 64 + fr, col0 = u.pn * BM + wc * 32 + 8 * fq;
#pragma unroll
        for (int ai = 0; ai < 2; ++ai)
#pragma unroll
            for (int m = 0; m < 4; ++m) {
                const int row = row0 + ai * HALF + m * 16;
                const size_t off = (size_t)row * D + col0;
                float ss = 0.f;
#pragma unroll
                for (int bj = 0; bj < 2; ++bj) {
                    f32x4 r0, r1;
                    if (resid32) { r0 = __builtin_nontemporal_load((const f32x4*)(resid32 + off + bj * HALF)); r1 = __builtin_nontemporal_load((const f32x4*)(resid32 + off + bj * HALF + 4)); }
                    else { const u32x4 rr = *(const u32x4*)(resid16 + off + bj * HALF);
                           r0 = (f32x4){bflo(rr.x), bfhi(rr.x), bflo(rr.y), bfhi(rr.y)}; r1 = (f32x4){bflo(rr.z), bfhi(rr.z), bflo(rr.w), bfhi(rr.w)}; }
                    const f32x4 v0 = acc[ai][bj][m][0] + r0, v1 = acc[ai][bj][m][1] + r1;
                    ss += ((v0[0] * v0[0] + v0[1] * v0[1]) + (v0[2] * v0[2] + v0[3] * v0[3])) + ((v1[0] * v1[0] + v1[1] * v1[1]) + (v1[2] * v1[2] + v1[3] * v1[3]));
                    u32x4 w; w.x = pk2(v0[0], v0[1]); w.y = pk2(v0[2], v0[3]); w.z = pk2(v1[0], v1[1]); w.w = pk2(v1[2], v1[3]);
                    *(u32x4*)(out16 + off + bj * HALF) = w;
                }
                if (sumsq) { ss += __shfl_xor(ss, 16); ss += __shfl_xor(ss, 32); if (fq == 0) atomicAdd(sumsq + row, ss); }
            }
    }
};

template <class Epi>
__device__ __forceinline__ void gemm_phase(LAS unsigned char* lds, const Gemm g, const StaticOrder& S, const Epi& E) {
    const int tid = threadIdx.x, wid = __builtin_amdgcn_readfirstlane(tid >> 6), lane = tid & 63, wr = wid >> 2, wc = wid & 3, fr = lane & 15, fq = lane >> 4;
    const int K = g.K, nt = K / BK, lda = g.lda;
    unsigned voffA[2], voffB[2];
#pragma unroll
    for (int i = 0; i < 2; ++i) { int R, C; stage_rc(tid * 16 + i * 8192, R, C); const int Rb = Epi::PERM ? ((R & ~31) + perm32(R & 31)) : R;
        voffA[i] = (unsigned)(R * lda + C) * 2u; voffB[i] = (unsigned)(Rb * K + C) * 2u; }
    const size_t kstep = (size_t)(BK * 2);
    const size_t hstepA = (size_t)HALF * lda * 2, hstepB = (size_t)HALF * K * 2;
    const size_t tstepA = 2 * hstepA, tstepB = 2 * hstepB;
    const unsigned ldsw = (unsigned)wid * 1024u;
    const int aoff = lds_byte(wr * 64 + fr, fq * 8), boff = lds_byte(wc * 32 + fr, fq * 8);
#define PG8_SA(b, h) (((b) * 2 + (h)) * HTB)
#define PG8_SB(b, h) ((4 + (b) * 2 + (h)) * HTB)
#define PG8_STAGE(bufoff, gbase, voff) do { _Pragma("unroll") for (int _i = 0; _i < 2; ++_i) \
        __builtin_amdgcn_global_load_lds((const unsigned*)((const char*)(gbase) + (voff)[_i]), (LAS unsigned*)(lds + (bufoff) + ldsw + _i * 8192), 16, 0, 0); } while (0)
#define PG8_LDA(dst, b, h) do { _Pragma("unroll") for (int m = 0; m < 4; ++m) _Pragma("unroll") for (int k = 0; k < 2; ++k) dst[m][k] = *(const LAS bf16x8*)(lds + PG8_SA(b, h) + aoff + m * 2048 + k * 1024); } while (0)
#define PG8_LDB(dst, b, h) do { _Pragma("unroll") for (int n = 0; n < 2; ++n) _Pragma("unroll") for (int k = 0; k < 2; ++k) dst[n][k] = *(const LAS bf16x8*)(lds + PG8_SB(b, h) + boff + n * 2048 + k * 1024); } while (0)
#define PG8_MMA(ai, bj, At, Bt) do { __builtin_amdgcn_s_setprio(1); _Pragma("unroll") for (int m = 0; m < 4; ++m) _Pragma("unroll") for (int n = 0; n < 2; ++n) _Pragma("unroll") for (int k = 0; k < 2; ++k) \
        acc[ai][bj][m][n] = __builtin_amdgcn_mfma_f32_16x16x32_bf16(Bt[n][k], At[m][k], acc[ai][bj][m][n], 0, 0, 0); __builtin_amdgcn_s_setprio(0); } while (0)
#define PG8_WAIT_V(n) asm volatile("s_waitcnt vmcnt(" #n ")" ::: "memory")
#define PG8_WAIT_L(n) asm volatile("s_waitcnt lgkmcnt(" #n ")" ::: "memory")
#define PG8_BAR __builtin_amdgcn_s_barrier()
#define PG8_SCHED __builtin_amdgcn_sched_barrier(0)
    Unit cur, nxt; int ui = 0;
    if (!S.next(0, cur)) return;
    f32x4 acc[2][2][4][2];
#pragma unroll
    for (int a = 0; a < 2; ++a)
#pragma unroll
        for (int b = 0; b < 2; ++b)
#pragma unroll
            for (int m = 0; m < 4; ++m)
#pragma unroll
                for (int n = 0; n < 2; ++n) acc[a][b][m][n] = (f32x4){0.f, 0.f, 0.f, 0.f};
    bf16x8 At[4][2], B0[2][2], B1[2][2];
    const char* cA = (const char*)g.A + (size_t)cur.pm * tstepA; const char* cB = (const char*)g.Bt + (size_t)cur.pn * tstepB;
    PG8_STAGE(PG8_SB(0, 0), cB, voffB); PG8_STAGE(PG8_SB(0, 1), cB + hstepB, voffB); PG8_STAGE(PG8_SA(0, 0), cA, voffA); PG8_STAGE(PG8_SA(0, 1), cA + hstepA, voffA);
    if (wr == 1) PG8_BAR;
    PG8_WAIT_V(2); PG8_BAR;
    PG8_STAGE(PG8_SB(1, 0), cB + kstep, voffB); PG8_STAGE(PG8_SA(1, 0), cA + kstep, voffA); PG8_STAGE(PG8_SB(1, 1), cB + hstepB + kstep, voffB);
    PG8_WAIT_V(6); PG8_BAR;
    for (;;) {
        const bool has_next = S.next(ui + 1, nxt);
        const char* nA = has_next ? (const char*)g.A + (size_t)nxt.pm * tstepA : cA; const char* nB = has_next ? (const char*)g.Bt + (size_t)nxt.pn * tstepB : cB;
        for (int t = 0; t < nt; t += 2) {
            const bool last = (t == nt - 2);
            const char* a1 = cA + (size_t)(t + 1) * kstep;
            const char* a2 = last ? nA : cA + (size_t)(t + 2) * kstep; const char* b2 = last ? nB : cB + (size_t)(t + 2) * kstep;
            const char* a3 = a2 + kstep; const char* b3 = b2 + kstep;
            PG8_LDB(B0, 0, 0); PG8_LDB(B1, 0, 1); PG8_SCHED; PG8_LDA(At, 0, 0); PG8_STAGE(PG8_SA(1, 1), a1 + hstepA, voffA);
            PG8_WAIT_V(8); PG8_WAIT_L(0); PG8_BAR; PG8_MMA(0, 0, At, B0); PG8_MMA(0, 1, At, B1); PG8_BAR; PG8_SCHED;
            PG8_LDA(At, 0, 1); PG8_STAGE(PG8_SB(0, 0), b2, voffB); PG8_STAGE(PG8_SB(0, 1), b2 + hstepB, voffB); PG8_STAGE(PG8_SA(0, 0), a2, voffA);
            PG8_WAIT_V(8); PG8_WAIT_L(0); PG8_BAR; PG8_MMA(1, 0, At, B0); PG8_MMA(1, 1, At, B1); PG8_BAR; PG8_SCHED;
            PG8_LDB(B0, 1, 0); PG8_LDB(B1, 1, 1); PG8_SCHED; PG8_LDA(At, 1, 0); PG8_STAGE(PG8_SA(0, 1), a2 + hstepA, voffA);
            PG8_WAIT_V(8); PG8_WAIT_L(0); PG8_BAR; PG8_MMA(0, 0, At, B0); PG8_MMA(0, 1, At, B1); PG8_BAR; PG8_SCHED;
            PG8_LDA(At, 1, 1); PG8_STAGE(PG8_SB(1, 0), b3, voffB); PG8_STAGE(PG8_SB(1, 1), b3 + hstepB, voffB); PG8_STAGE(PG8_SA(1, 0), a3, voffA);
            PG8_WAIT_V(8); PG8_WAIT_L(0); PG8_BAR; PG8_MMA(1, 0, At, B0); PG8_MMA(1, 1, At, B1); PG8_BAR; PG8_SCHED;
        }
        if (wr == 0) PG8_BAR;
        E(acc, cur, wr, wc, fr, fq);
        if (!has_next) break;
#pragma unroll
        for (int a = 0; a < 2; ++a)
#pragma unroll
            for (int b = 0; b < 2; ++b)
#pragma unroll
                for (int m = 0; m < 4; ++m)
#pragma unroll
                    for (int n = 0; n < 2; ++n) acc[a][b][m][n] = (f32x4){0.f, 0.f, 0.f, 0.f};
        cur = nxt; cA = nA; cB = nB; ++ui;
        if (wr == 1) PG8_BAR;
    }
    PG8_WAIT_V(0);
    PG8_BAR;
#undef PG8_SA
#undef PG8_SB
#undef PG8_STAGE
#undef PG8_LDA
#undef PG8_LDB
#undef PG8_MMA
#undef PG8_WAIT_V
#undef PG8_WAIT_L
#undef PG8_BAR
#undef PG8_SCHED
}
}

constexpr int QT_OFF = 0, KH_OFF = 33792, KT_OFF = 67584, VT_OFF = 104448, PB_OFF = 122880, EV_OFF = 132096, TOT_OFF = 133120;
constexpr int QSTR = 264, TSTR = 72;
#define MFMA32(a, b, c) __builtin_amdgcn_mfma_f32_32x32x16_bf16((a), (b), (c), 0, 0, 0)
__device__ __forceinline__ int crow(int i, int h) { return (i & 3) + 8 * (i >> 2) + 4 * h; }

template <int MODE>
__device__ __forceinline__ void prescan_phase(LAS unsigned char* lds, bf16_t* proj, unsigned char* pf_ext, int vcu, int G, const float* ubuf = nullptr, const float* w_a2 = nullptr, const float* b_a = nullptr) {
    constexpr int H = MODE ? 8 : 4, LD = MODE ? N1 : N0, KOFF = MODE ? 2048 : 1024, AOFF = 10240, NIT = 8 * H * 64;
    const int tid = threadIdx.x, lane = tid & 63, w = __builtin_amdgcn_readfirstlane(tid >> 6);
    const int r = lane & 31, h2 = lane >> 5;
    const int cp = tid & 127, sq = w >> 1;
    LAS float* EV = (LAS float*)(lds + EV_OFF);
    LAS float* TOT = (LAS float*)(lds + TOT_OFF);
    const unsigned qlo = ((unsigned)(16 * sq) * LD + 2 * cp) * 2u;
    const unsigned flo = (unsigned)h2 * (LD * 2) + r * 16;
    unsigned rq[16], rk[16], ra[16];
    f32x2 ru = (f32x2){0.f, 0.f}, w2[16], b2 = (f32x2){0.f, 0.f};
    LAS float* UL = (LAS float*)(lds + TOT_OFF + 4096);
#define PRE_BASE(it) (proj + ((size_t)((it) / (64 * H)) * SEQ + (size_t)((it) % 64) * 64) * LD + (((it) / 64) % H) * 256)
#define PRE_LOAD(it) do { const char* _p = (const char*)PRE_BASE(it); \
        _Pragma("unroll") for (int i = 0; i < 16; ++i) { const char* _pi = _p + (size_t)i * (LD * 2); \
            rq[i] = __builtin_nontemporal_load((const unsigned*)(_pi + qlo)); rk[i] = __builtin_nontemporal_load((const unsigned*)(_pi + KOFF * 2 + qlo)); \
            } \
        if (MODE == 0) { const int _hh = ((it) / 64) % H; const size_t _r0 = (size_t)((it) / (64 * H)) * SEQ + (size_t)((it) % 64) * 64; \
            ru = *(const f32x2*)(ubuf + _r0 * 16 + 2 * tid); b2 = *(const f32x2*)(b_a + _hh * 256 + 2 * cp); \
            _Pragma("unroll") for (int r_ = 0; r_ < 16; ++r_) w2[r_] = *(const f32x2*)(w_a2 + r_ * 1024 + _hh * 256 + 2 * cp); } } while (0)
    if (vcu < NIT) PRE_LOAD(vcu);
    for (int item = vcu; item < NIT; item += G) {
        const int hh = (item / 64) % H;
        char* qseg = (char*)PRE_BASE(item);
        const float lg = MODE ? log1pf(-exp2f(-5.0f - (float)hh)) : 0.f;
        if (MODE == 0) {
            *(LAS f32x2*)(UL + 2 * tid) = ru;
            __syncthreads();
#pragma unroll
            for (int i = 0; i < 16; ++i) {
                const LAS f32x4* ur = (const LAS f32x4*)(UL + (16 * sq + i) * 16);
                float x0 = b2[0], x1 = b2[1];
#pragma unroll
                for (int q4 = 0; q4 < 4; ++q4) { const f32x4 uv = ur[q4];
#pragma unroll
                    for (int e = 0; e < 4; ++e) { x0 += uv[e] * w2[4 * q4 + e][0]; x1 += uv[e] * w2[4 * q4 + e][1]; } }
                const float l0 = (fminf(x0, 0.f) - __logf(1.0f + __expf(-fabsf(x0)))) * (1.0f / 16.0f);
                const float l1 = (fminf(x1, 0.f) - __logf(1.0f + __expf(-fabsf(x1)))) * (1.0f / 16.0f);
                ra[i] = pk2(l0, l1);
            }
        }
        float run0 = 0.f, run1 = 0.f;
        if (MODE == 0) {
            float a0 = 0.f, a1 = 0.f;
#pragma unroll
            for (int i = 0; i < 16; ++i) { a0 += bflo(ra[i]); a1 += bfhi(ra[i]); }
            *(LAS f32x2*)(TOT + sq * 256 + 2 * cp) = (f32x2){a0, a1};
        }
        __syncthreads();
        float lgc = lg;
        if (MODE == 0) {
#pragma unroll
            for (int q = 0; q < 3; ++q) if (q < sq) { const f32x2 t = *(LAS f32x2*)(TOT + q * 256 + 2 * cp); run0 += t[0]; run1 += t[1]; }
        } else {
            asm volatile("" : "+v"(lgc));
        }
#pragma unroll
        for (int hf = 0; hf < 2; ++hf) {
            unsigned kt0[4], kt1[4];
#pragma unroll
            for (int ii = 0; ii < 8; ii += 2) {
                float ka[2], kb2[2];
#pragma unroll
                for (int d = 0; d < 2; ++d) {
                    const int i = 8 * hf + ii + d, s = 16 * sq + i;
                    float cu0, cu1;
                    if (MODE == 0) { run0 += bflo(ra[i]); run1 += bfhi(ra[i]); cu0 = run0; cu1 = run1; }
                    else { cu0 = lgc * (float)(s + 1); cu1 = cu0; }
                    const float e0 = __expf(cu0), e1 = __expf(cu1), f0 = __expf(-cu0), f1 = __expf(-cu1);
                    *(LAS unsigned*)(lds + QT_OFF + (s * QSTR + 2 * cp) * 2) = pk2(bflo(rq[i]) * e0, bfhi(rq[i]) * e1);
                    ka[d] = bflo(rk[i]) * f0; kb2[d] = bfhi(rk[i]) * f1;
                    *(LAS unsigned*)(lds + KH_OFF + (s * QSTR + 2 * cp) * 2) = pk2(ka[d], kb2[d]);
                    if (MODE == 0 && i == 15 && sq == 3) *(LAS f32x2*)(EV + 2 * cp) = (f32x2){e0, e1};
                }
                kt0[ii >> 1] = pk2(ka[0], ka[1]); kt1[ii >> 1] = pk2(kb2[0], kb2[1]);
            }
            LAS unsigned char* kt = lds + KT_OFF + ((2 * cp) * TSTR + 16 * sq + 8 * hf) * 2;
            *(LAS u32x4*)(kt) = (u32x4){kt0[0], kt0[1], kt0[2], kt0[3]};
            *(LAS u32x4*)(kt + TSTR * 2) = (u32x4){kt1[0], kt1[1], kt1[2], kt1[3]};
        }
        __syncthreads();
        if (item + G < NIT) PRE_LOAD(item + G);
        if (w < 3) {
            const int tb = (w >= 1) ? 1 : 0, sb = (w == 2) ? 1 : 0;
            f32x16 P;
#pragma unroll
            for (int i = 0; i < 16; ++i) P[i] = 0.f;
            const LAS unsigned char* qa = lds + QT_OFF + ((32 * tb + r) * QSTR + 8 * h2) * 2;
            const LAS unsigned char* kb_ = lds + KH_OFF + ((32 * sb + r) * QSTR + 8 * h2) * 2;
#pragma unroll
            for (int st = 0; st < 16; ++st) P = MFMA32(*(const LAS bf16x8*)(qa + st * 32), *(const LAS bf16x8*)(kb_ + st * 32), P);
            LAS bf16_t* pb = (LAS bf16_t*)(lds + PB_OFF);
#pragma unroll
            for (int i = 0; i < 16; ++i) {
                const int tr = crow(i, h2);
                const float pv = (tb == sb && r > tr) ? 0.f : P[i];
                pb[(32 * tb + tr) * TSTR + 32 * sb + r] = (bf16_t)(pk2(pv, 0.f) & 0xffffu);
            }
        }
#pragma unroll
        for (int i = 0; i < 4; ++i) {
            const int f = 4 * w + i, tb = f & 1, st = (f >> 1) & 1, kb = f >> 2;
            const LAS unsigned char* q0 = lds + QT_OFF + ((32 * tb + r) * QSTR + 32 * kb + 16 * st + 4 * h2) * 2;
            const u32x2 lo = *(const LAS u32x2*)(q0), hi = *(const LAS u32x2*)(q0 + 16);
            *(u32x4*)(qseg + (size_t)(2 * f) * (LD * 2) + flo) = (u32x4){lo.x, lo.y, hi.x, hi.y};
        }
#pragma unroll
        for (int i = 0; i < 4; ++i) {
            const int f = 4 * w + i, st = i, kb = w;
            const u32x4 kv = *(const LAS u32x4*)(lds + KT_OFF + ((32 * kb + r) * TSTR + 16 * st + 8 * h2) * 2);
            *(u32x4*)(qseg + KOFF * 2 + (size_t)(2 * f) * (LD * 2) + flo) = kv;
        }
        __syncthreads();
        if (w != 2 && w != 3) {
            const int tb = w >> 2, st = w & 3;
            const u32x4 pv = *(const LAS u32x4*)(lds + PB_OFF + ((32 * tb + r) * TSTR + 16 * st + 8 * h2) * 2);
            if (MODE == 0) *(u32x4*)(qseg + AOFF * 2 + (size_t)(2 * w) * (LD * 2) + flo) = pv;
            else *(u32x4*)(pf_ext + (size_t)item * 8192 + w * 1024 + lane * 16) = pv;
        } else if (MODE == 0 && w == 2) {
            const f32x4 ev = *(const LAS f32x4*)(EV + 4 * lane);
            *(f32x4*)(qseg + AOFF * 2 + (size_t)16 * (LD * 2) + flo) = ev;
        }
    }
#undef PRE_LOAD
#undef PRE_BASE
    __syncthreads();
}

constexpr int QB_OFF = 0, KB_OFF = 32768, VT2_OFF = 98304, EV2_OFF = 116736, XCH_OFF = 118784;
template <int MODE>
__device__ __forceinline__ void scan_phase(LAS unsigned char* lds, bf16_t* proj, const unsigned char* pf_ext, int vcu, int G) {
    constexpr int H = MODE ? 8 : 4, DV = MODE ? 512 : 1024, NSL = DV / 128, LD = MODE ? N1 : N0;
    constexpr int KOFF = MODE ? 2048 : 1024, VOFF = MODE ? 4096 : 2048, AOFF = 10240;
    const int tid = threadIdx.x, lane = tid & 63, w = __builtin_amdgcn_readfirstlane(tid >> 6);
    const int r = lane & 31, h2 = lane >> 5, vb = w & 3, kh = w >> 2;
    const int vp = lane, s8 = w;
    LAS float* XCH = (LAS float*)(lds + XCH_OFF);
    const unsigned flo = (unsigned)h2 * (LD * 2) + r * 16;
    const unsigned vlo = ((unsigned)(8 * s8) * LD + 2 * vp) * 2u;
    for (int item = vcu; item < 256; item += G) {
        const int vs = item % NSL, hh = (item / NSL) % H, b = item / (NSL * H);
        const size_t rowb = (size_t)b * SEQ;
        const char* qseg0 = (const char*)(proj + rowb * LD + hh * 256);
        bf16_t* vbase = proj + rowb * LD + VOFF + hh * DV + vs * 128;
        const unsigned char* pfb = pf_ext + (size_t)((b * H + hh) * 64) * 8192;
        const float gdec = MODE ? __expf(64.0f * log1pf(-exp2f(-5.0f - (float)hh))) : 1.0f;
        f32x16 S[4];
#pragma unroll
        for (int j = 0; j < 4; ++j)
#pragma unroll
            for (int i = 0; i < 16; ++i) S[j][i] = 0.f;
        unsigned rv[8]; u32x4 pf[4]; f32x16 oprev;
#define SC_SEG(c) (qseg0 + (size_t)((c) * 64) * (LD * 2))
#define SC_DMA(c) do { const char* _s = SC_SEG(c); const int _b = (c) & 1; \
            _Pragma("unroll") for (int i = 0; i < 4; ++i) __builtin_amdgcn_global_load_lds((const unsigned*)(_s + KOFF * 2 + (size_t)(2 * (4 * w + i)) * (LD * 2) + flo), (LAS unsigned*)(lds + KB_OFF + _b * 32768 + (4 * w + i) * 1024), 16, 0, 0); \
            _Pragma("unroll") for (int i = 0; i < 4; ++i) __builtin_amdgcn_global_load_lds((const unsigned*)(_s + (size_t)(2 * (4 * w + i)) * (LD * 2) + flo), (LAS unsigned*)(lds + QB_OFF + (4 * w + i) * 1024), 16, 0, 0); \
            if (MODE == 0 && w == 0) __builtin_amdgcn_global_load_lds((const unsigned*)(_s + AOFF * 2 + (size_t)16 * (LD * 2) + flo), (LAS unsigned*)(lds + EV2_OFF + _b * 1024), 16, 0, 0); } while (0)
#define SC_LOADV(c) do { const char* _v = (const char*)(vbase + (size_t)((c) * 64) * LD); \
            _Pragma("unroll") for (int i = 0; i < 8; ++i) rv[i] = __builtin_nontemporal_load((const unsigned*)(_v + (size_t)i * (LD * 2) + vlo)); } while (0)
#define SC_LOADP(c) do { _Pragma("unroll") for (int st = 0; st < 4; ++st) if (st < 2 || kh) { \
            if (MODE == 0) pf[st] = *(const u32x4*)(SC_SEG(c) + AOFF * 2 + (size_t)(2 * (4 * kh + st)) * (LD * 2) + flo); \
            else pf[st] = *(const u32x4*)(pfb + (size_t)(c) * 8192 + (4 * kh + st) * 1024 + lane * 16); } } while (0)
        SC_DMA(0); SC_LOADV(0); SC_LOADP(0);
        for (int c = 0; c < 64; ++c) {
            {
                u32x4 v0, v1;
                v0.x = (rv[0] & 0xffffu) | (rv[1] << 16); v0.y = (rv[2] & 0xffffu) | (rv[3] << 16); v0.z = (rv[4] & 0xffffu) | (rv[5] << 16); v0.w = (rv[6] & 0xffffu) | (rv[7] << 16);
                v1.x = (rv[0] >> 16) | (rv[1] & 0xffff0000u); v1.y = (rv[2] >> 16) | (rv[3] & 0xffff0000u); v1.z = (rv[4] >> 16) | (rv[5] & 0xffff0000u); v1.w = (rv[6] >> 16) | (rv[7] & 0xffff0000u);
                LAS unsigned char* vt = lds + VT2_OFF + ((2 * vp) * TSTR + 8 * s8) * 2;
                *(LAS u32x4*)(vt) = v0; *(LAS u32x4*)(vt + TSTR * 2) = v1;
            }
            asm volatile("s_waitcnt vmcnt(0)" ::: "memory");
            __syncthreads();
            if (c > 0) {
                char* op = (char*)(vbase + (size_t)((c - 1) * 64 + 32 * kh) * LD);
                const unsigned olo = ((unsigned)(4 * h2) * LD + 32 * vb + r) * 2u;
#pragma unroll
                for (int i = 0; i < 16; ++i) __builtin_nontemporal_store((bf16_t)(pk2(oprev[i], 0.f) & 0xffffu), (bf16_t*)(op + (size_t)((i & 3) + 8 * (i >> 2)) * (LD * 2) + olo));
            }
            if (c + 1 < 64) SC_LOADV(c + 1);
            f32x16 op0, op1;
#pragma unroll
            for (int i = 0; i < 16; ++i) { op0[i] = 0.f; op1[i] = 0.f; }
#pragma unroll
            for (int j = 0; j < 4; ++j) {
#pragma unroll
                for (int st = 0; st < 2; ++st) {
                    u32x4 sp; sp.x = pk2(S[j][8 * st + 0], S[j][8 * st + 1]); sp.y = pk2(S[j][8 * st + 2], S[j][8 * st + 3]); sp.z = pk2(S[j][8 * st + 4], S[j][8 * st + 5]); sp.w = pk2(S[j][8 * st + 6], S[j][8 * st + 7]);
                    const bf16x8 sfrag = __builtin_bit_cast(bf16x8, sp);
                    const LAS unsigned char* qf = lds + QB_OFF + ((((4 * kh + j) * 2 + st) * 2) * 1024) + lane * 16;
                    op0 = MFMA32(*(const LAS bf16x8*)(qf), sfrag, op0);
                    op1 = MFMA32(*(const LAS bf16x8*)(qf + 1024), sfrag, op1);
                }
            }
            __syncthreads();
            if (c + 1 < 64) SC_DMA(c + 1);
            f32x16 o;
#pragma unroll
            for (int i = 0; i < 16; ++i) { XCH[w * 1024 + i * 64 + lane] = kh ? op0[i] : op1[i]; o[i] = kh ? op1[i] : op0[i]; }
            bf16x8 vf[4];
#pragma unroll
            for (int st = 0; st < 4; ++st) vf[st] = *(const LAS bf16x8*)(lds + VT2_OFF + ((32 * vb + r) * TSTR + 16 * st + 8 * h2) * 2);
            o = MFMA32(__builtin_bit_cast(bf16x8, pf[0]), vf[0], o);
            o = MFMA32(__builtin_bit_cast(bf16x8, pf[1]), vf[1], o);
            if (kh) { o = MFMA32(__builtin_bit_cast(bf16x8, pf[2]), vf[2], o); o = MFMA32(__builtin_bit_cast(bf16x8, pf[3]), vf[3], o); }
            if (c + 1 < 64) SC_LOADP(c + 1);
            const LAS unsigned char* kfb = lds + KB_OFF + (c & 1) * 32768 + lane * 16;
            const LAS float* EVc = (const LAS float*)(lds + EV2_OFF + (c & 1) * 1024);
#pragma unroll
            for (int j = 0; j < 4; ++j) {
                const int kb = 4 * kh + j;
#pragma unroll
                for (int st = 0; st < 4; ++st) S[j] = MFMA32(*(const LAS bf16x8*)(kfb + (kb * 4 + st) * 1024), vf[st], S[j]);
                if (MODE == 0) {
#pragma unroll
                    for (int g4 = 0; g4 < 4; ++g4) { const f32x4 e = *(const LAS f32x4*)(EVc + 32 * kb + 8 * g4 + 4 * h2);
#pragma unroll
                        for (int q = 0; q < 4; ++q) S[j][4 * g4 + q] *= e[q]; }
                } else {
#pragma unroll
                    for (int i = 0; i < 16; ++i) S[j][i] *= gdec;
                }
            }
            __syncthreads();
#pragma unroll
            for (int i = 0; i < 16; ++i) oprev[i] = o[i] + XCH[(w ^ 4) * 1024 + i * 64 + lane];
        }
        {
            char* op = (char*)(vbase + (size_t)(63 * 64 + 32 * kh) * LD);
            const unsigned olo = ((unsigned)(4 * h2) * LD + 32 * vb + r) * 2u;
#pragma unroll
            for (int i = 0; i < 16; ++i) __builtin_nontemporal_store((bf16_t)(pk2(oprev[i], 0.f) & 0xffffu), (bf16_t*)(op + (size_t)((i & 3) + 8 * (i >> 2)) * (LD * 2) + olo));
        }
#undef SC_SEG
#undef SC_DMA
#undef SC_LOADV
#undef SC_LOADP
        asm volatile("s_waitcnt vmcnt(0)" ::: "memory");
        __syncthreads();
    }
}

template <int MODE>
__device__ __forceinline__ void ew_phase(bf16_t* proj, const float* gain, const float* bias, int gw, int NGW, int lane) {
    constexpr int H = MODE ? 8 : 4, DV = MODE ? 512 : 1024, LD = MODE ? N1 : N0, NC = DV / 512;
    constexpr int VOFF = MODE ? 4096 : 2048, GOFF = VOFF + DI;
    for (int p = gw; p < T * H; p += NGW) {
        const int t = p / H, hh = p % H;
        bf16_t* orow = proj + (size_t)t * LD + VOFF + hh * DV;
        const bf16_t* grow = proj + (size_t)t * LD + GOFF + hh * DV;
        u32x4 ov[NC], gv[NC];
#pragma unroll
        for (int cc = 0; cc < NC; ++cc) { ov[cc] = __builtin_nontemporal_load((const u32x4*)(orow + cc * 512 + lane * 8)); gv[cc] = __builtin_nontemporal_load((const u32x4*)(grow + cc * 512 + lane * 8)); }
        float s1 = 0.f, s2 = 0.f;
#pragma unroll
        for (int cc = 0; cc < NC; ++cc)
#pragma unroll
            for (int q = 0; q < 4; ++q) { const float oa = bflo(ov[cc][q]), ob = bfhi(ov[cc][q]); s1 += oa + ob; s2 += oa * oa + ob * ob; }
        s1 = wave_sum(s1); s2 = wave_sum(s2);
        float mu = 0.f, rs;
        if (MODE == 0) rs = rsqrtf(s2 * (1.0f / DV) + EPS);
        else { mu = s1 * (1.0f / DV); rs = rsqrtf(fmaxf(s2 * (1.0f / DV) - mu * mu, 0.f) + EPS); }
#pragma unroll
        for (int cc = 0; cc < NC; ++cc) {
            const int col = cc * 512 + lane * 8;
            const f32x4 g0 = *(const f32x4*)(gain + hh * DV + col), g1 = *(const f32x4*)(gain + hh * DV + col + 4);
            f32x4 b0 = (f32x4){0.f, 0.f, 0.f, 0.f}, b1 = b0;
            if (MODE == 1) { b0 = *(const f32x4*)(bias + hh * DV + col); b1 = *(const f32x4*)(bias + hh * DV + col + 4); }
            const float gg[8] = {g0[0], g0[1], g0[2], g0[3], g1[0], g1[1], g1[2], g1[3]}, bb[8] = {b0[0], b0[1], b0[2], b0[3], b1[0], b1[1], b1[2], b1[3]};
            u32x4 res;
#pragma unroll
            for (int q = 0; q < 4; ++q) {
                const float oa = bflo(ov[cc][q]), ob = bfhi(ov[cc][q]), ga = bflo(gv[cc][q]), gb = bfhi(gv[cc][q]);
                const float ya = ((oa - mu) * rs * gg[2 * q] + bb[2 * q]) * (ga / (1.0f + __expf(-ga)));
                const float yb = ((ob - mu) * rs * gg[2 * q + 1] + bb[2 * q + 1]) * (gb / (1.0f + __expf(-gb)));
                res[q] = pk2(ya, yb);
            }
            *(u32x4*)(orow + col) = res;
        }
    }
}

__device__ __forceinline__ void p0_transpose_item(const float* W, int K, int N, bf16_t* WT, int row_off, LAS float* scr, int item, int lane, const float* kvec, int sc0, int sc1, float sc) {
    const int nblk = N / 32, kb = item / nblk, nb = item % nblk, k0 = 64 * kb, n0 = 32 * nb;
    const float cs = (n0 >= sc0 && n0 < sc1) ? sc : 1.0f;
#pragma unroll 8
    for (int i = 0; i < 32; ++i) { const int kk = 2 * i + (lane >> 5); const float kv = kvec ? kvec[k0 + kk] : 1.0f; scr[kk * 33 + (lane & 31)] = __builtin_nontemporal_load(W + (size_t)(k0 + kk) * N + n0 + (lane & 31)) * (kv * cs); }
    asm volatile("s_waitcnt lgkmcnt(0)" ::: "memory");
    const int c = lane & 7;
#pragma unroll
    for (int j = 0; j < 4; ++j) { const int n = (lane >> 3) + 8 * j; const LAS float* s = scr + (8 * c) * 33 + n;
        u32x4 o; o.x = pk2(s[0 * 33], s[1 * 33]); o.y = pk2(s[2 * 33], s[3 * 33]); o.z = pk2(s[4 * 33], s[5 * 33]); o.w = pk2(s[6 * 33], s[7 * 33]);
        *(u32x4*)(WT + (size_t)(row_off + n0 + n) * K + k0 + 8 * c) = o; }
    asm volatile("s_waitcnt lgkmcnt(0)" ::: "memory");
}

#define XB_TMO      128
#define XB_XCNT(j)  (256  + 64 * (j))
#define XB_XSUB(j)  (1280 + 64 * (j))
#define XB_XGEN(j)  (2304 + 64 * (j))
#define XB_TOP      3328
#define XB_TOPGEN   3392
#define XCD_BAR_WORDS 3456
#define XB_SPIN_CAP (1u << 18)

__device__ __forceinline__ unsigned xb_ld(unsigned* p)              { return __hip_atomic_load(p, __ATOMIC_RELAXED, __HIP_MEMORY_SCOPE_AGENT); }
__device__ __forceinline__ unsigned xb_add(unsigned* p, unsigned v) { return __hip_atomic_fetch_add(p, v, __ATOMIC_RELAXED, __HIP_MEMORY_SCOPE_AGENT); }
__device__ __forceinline__ unsigned xb_xcc_id() { return (unsigned)__builtin_amdgcn_s_getreg((3 << 11) | 20) & 0xFu; }
#define XB_SPIN(cond, bar) do { unsigned _sp = 0; while (cond) { __builtin_amdgcn_s_sleep(1); \
    if ((++_sp & 255u) == 0u) { if (xb_ld(&(bar)[XB_TMO])) break; if (_sp > XB_SPIN_CAP) { atomicAdd(&(bar)[XB_TMO], 1u); break; } } } } while (0)

struct XcdBarrier {
    unsigned* bar; unsigned x;
    volatile LAS unsigned* st;
};

__device__ __forceinline__ XcdBarrier xcd_barrier_post(unsigned* bar, volatile LAS unsigned* st) {
    XcdBarrier b; b.bar = bar; b.x = xb_xcc_id(); b.st = st;
    if (threadIdx.x == 0) st[2] = xb_add(&bar[XB_XCNT(b.x)], 1u);
    return b;
}
__device__ __forceinline__ void xcd_barrier_complete(unsigned* bar, unsigned x, unsigned& nloc, unsigned& nx) {
    const unsigned G = gridDim.x * gridDim.y * gridDim.z;
    unsigned sum, cnt, mine, sp = 0u;
    for (;;) {
        sum = 0u; cnt = 0u; mine = 0u;
#pragma unroll
        for (unsigned j = 0; j < 16; ++j) { const unsigned c = xb_ld(&bar[XB_XCNT(j)]); sum += c; cnt += (c > 0u) ? 1u : 0u; mine = (j == x) ? c : mine; }
        if (sum == G) break;
        __builtin_amdgcn_s_sleep(1);
        if ((++sp & 255u) == 0u) { if (xb_ld(&bar[XB_TMO])) break; if (sp > XB_SPIN_CAP) { atomicAdd(&bar[XB_TMO], 1u); break; } }
    }
    nloc = mine > 0u ? mine : 1u; nx = cnt > 0u ? cnt : 1u;
}

__device__ __forceinline__ void xcd_barrier(const XcdBarrier& b) {
    asm volatile("s_waitcnt vmcnt(0)" ::: "memory");
    __syncthreads();
    if (threadIdx.x == 0) {
        unsigned* bar = b.bar;
        __builtin_amdgcn_s_waitcnt(0);
        unsigned nloc = b.st[0], nx = b.st[1];
        if (nloc == 0u) { xcd_barrier_complete(bar, b.x, nloc, nx); b.st[0] = nloc; b.st[1] = nx; }
        const unsigned old = xb_add(&bar[XB_XSUB(b.x)], 1u);
        const unsigned gen = old / nloc;
        if (old + 1u == (gen + 1u) * nloc) {
            __builtin_amdgcn_fence(__ATOMIC_RELEASE, "agent");
            asm volatile("s_waitcnt vmcnt(0)" ::: "memory");
            const unsigned og = xb_add(&bar[XB_TOP], 1u);
            const unsigned tg = og / nx;
            if (og + 1u == (tg + 1u) * nx) xb_add(&bar[XB_TOPGEN], 1u);
            else XB_SPIN(xb_ld(&bar[XB_TOPGEN]) == tg, bar);
            __builtin_amdgcn_fence(__ATOMIC_ACQUIRE, "agent");
            xb_add(&bar[XB_XGEN(b.x)], 1u);
            asm volatile("s_waitcnt vmcnt(0)" ::: "memory");
        } else {
            XB_SPIN(xb_ld(&bar[XB_XGEN(b.x)]) == gen, bar);
            __builtin_amdgcn_fence(__ATOMIC_ACQUIRE, "agent");
            asm volatile("s_waitcnt vmcnt(0)" ::: "memory");
        }
    }
    __syncthreads();
}

struct Args {
    const float* x; const int* pos;
    const float *gla_norm, *gla_w_in, *gla_w_a1, *gla_w_a2, *gla_b_a, *gla_head_g, *gla_w_out;
    const float *ret_norm, *ret_w_in, *ret_gn_g, *ret_gn_b, *ret_w_out, *final_norm;
    float* out; unsigned char* ws;
};

__global__ void __launch_bounds__(512, 2) fwd(Args a) {
    extern __shared__ __attribute__((aligned(16))) unsigned char lds_raw[];
    LAS unsigned char* lds = (LAS unsigned char*)lds_raw;
    cg::grid_group grid = cg::this_grid();
    const int tid = threadIdx.x, lane = tid & 63, wave = __builtin_amdgcn_readfirstlane(tid >> 6);
    const int G = gridDim.x, bx = blockIdx.x;
    const int vcu = (G % 8 == 0) ? (bx % 8) * (G / 8) + bx / 8 : bx;
    const int gw = vcu * 8 + wave, NGW = G * 8;
    const int gtid = bx * 512 + tid, NGT = G * 512;
    unsigned char* ws = a.ws;
    if (tid < 4) ((LAS unsigned*)(lds + LDS_BARW))[tid] = 0u;
    __syncthreads();
    XcdBarrier xbar = xcd_barrier_post((unsigned*)(ws + WS_BAR), (volatile LAS unsigned*)(lds + LDS_BARW));
    bf16_t* W0T = (bf16_t*)(ws + WS_W0T); bf16_t* WOUT0T = (bf16_t*)(ws + WS_WOUT0T); bf16_t* W1T = (bf16_t*)(ws + WS_W1T); bf16_t* WOUT1T = (bf16_t*)(ws + WS_WOUT1T);
    bf16_t* H1BF = (bf16_t*)(ws + WS_H1BF); bf16_t* PROJ = (bf16_t*)(ws + WS_PROJ);
    bf16_t* HN = (bf16_t*)a.out;
    f32x2* ROT = (f32x2*)(ws + WS_ROT); float* SUMSQ1 = (float*)(ws + WS_SUMSQ1); float* UBUF = (float*)(ws + 61 * MiB);

#ifdef PROBE_A
    unsigned long long* TS = (unsigned long long*)(ws + 60 * MiB);
    int nst = 0;
#define STAMP() do { if (bx == 0 && tid == 0) TS[nst] = __builtin_amdgcn_s_memrealtime(); ++nst; } while (0)
#else
#define STAMP() do {} while (0)
#endif
    STAMP();
    {
        LAS float* scr = (LAS float*)(lds + wave * 8704);
        constexpr int I_W0 = (D / 64) * (10240 / 32), I_WO = (DI / 64) * (D / 32), I_W1 = (D / 64) * (N1 / 32);
        constexpr int NITEMS = I_W0 + I_WO + I_W1 + I_WO;
        for (int it = gw; it < NITEMS; it += NGW) {
            int q = it;
            if (q < I_W0) { p0_transpose_item(a.gla_w_in, D, 10240, W0T, 0, scr, q, lane, nullptr, 0, 1024, 0.0625f); continue; } q -= I_W0;
            if (q < I_WO) { p0_transpose_item(a.gla_w_out, DI, D, WOUT0T, 0, scr, q, lane, nullptr, 0, 0, 1.0f); continue; } q -= I_WO;
            if (q < I_W1) { p0_transpose_item(a.ret_w_in, D, N1, W1T, 0, scr, q, lane, a.ret_norm, 2048, 4096, 0.0625f); continue; } q -= I_W1;
            p0_transpose_item(a.ret_w_out, DI, D, WOUT1T, 0, scr, q, lane, nullptr, 0, 0, 1.0f);
        }
        for (int idx = gtid; idx < 256 * 256; idx += NGT) {
            const int rr = idx >> 8, kc = idx & 255;
            u32x4 o = (u32x4){0u, 0u, 0u, 0u};
            if (rr < 16) {
                float v[8];
#pragma unroll
                for (int kk = 0; kk < 8; ++kk) v[kk] = a.gla_w_a1[(size_t)(8 * kc + kk) * 16 + rr];
                o = (u32x4){pk2(v[0], v[1]), pk2(v[2], v[3]), pk2(v[4], v[5]), pk2(v[6], v[7])};
            }
            *(u32x4*)(W0T + (size_t)(10240 + rr) * D + 8 * kc) = o;
        }
        for (int m = gw; m < T; m += NGW) {
            const f32x4* xr = (const f32x4*)(a.x + (size_t)m * D) + lane;
            const f32x4* gr = (const f32x4*)a.gla_norm + lane;
            f32x4 v[8]; float s = 0.f;
#pragma unroll
            for (int j = 0; j < 8; ++j) { v[j] = __builtin_nontemporal_load(xr + 64 * j); s += (v[j][0] * v[j][0] + v[j][1] * v[j][1]) + (v[j][2] * v[j][2] + v[j][3] * v[j][3]); }
            const float rs = rsqrtf(wave_sum(s) * (1.0f / D) + EPS);
            u32x2* o8 = (u32x2*)(HN + (size_t)m * D) + lane;
#pragma unroll
            for (int j = 0; j < 8; ++j) { const f32x4 g = gr[64 * j]; o8[64 * j] = (u32x2){pk2(v[j][0] * rs * g[0], v[j][1] * rs * g[1]), pk2(v[j][2] * rs * g[2], v[j][3] * rs * g[3])}; }
        }
    }
    if (a.ws == nullptr) grid.sync();
    xcd_barrier(xbar); STAMP();
    int pcu;
    {
        volatile LAS unsigned* bst = (volatile LAS unsigned*)(lds + LDS_BARW);
        if (tid == 0) {
            const unsigned* bw = (const unsigned*)(ws + WS_BAR);
            unsigned base = 0u;
            for (unsigned j = 0; j < 16; ++j) { const unsigned cj = __hip_atomic_load(bw + XB_XCNT(j), __ATOMIC_RELAXED, __HIP_MEMORY_SCOPE_AGENT); if (j < xbar.x) base += cj; }
            bst[3] = base + bst[2];
        }
        __syncthreads();
        pcu = (int)bst[3];
        if (pcu < 0 || pcu >= G) pcu = vcu;
    }
    {
        pg8::Gemm g{HN, W0T, T, N0G, D, D}; pg8::StaticOrder S; S.init(T, N0G, G, bx);
        pg8::EpiProj E{PROJ, N0, 0, nullptr, UBUF, nullptr};
        pg8::gemm_phase<pg8::EpiProj>(lds, g, S, E);
    }
    xcd_barrier(xbar); STAMP();
    prescan_phase<0>(lds, PROJ, nullptr, pcu, G, UBUF, a.gla_w_a2, a.gla_b_a);
    xcd_barrier(xbar); STAMP();
    scan_phase<0>(lds, PROJ, nullptr, pcu, G);
    xcd_barrier(xbar); STAMP();
    {
        ew_phase<0>(PROJ, a.gla_head_g, nullptr, gw, NGW, lane);
        for (int idx = gtid; idx < T * 128; idx += NGT) {
            const int t = idx >> 7, i = idx & 127;
            const double invf = exp(-(double)i * (9.210340371976184 / 128.0));
            const double ang = (double)a.pos[t] * invf;
            double rev = ang * 0.15915494309189535; rev -= floor(rev);
            const float fr = (float)rev;
            ROT[idx] = (f32x2){__builtin_amdgcn_cosf(fr), __builtin_amdgcn_sinf(fr)};
        }
        for (int idx = gtid; idx < T; idx += NGT) SUMSQ1[idx] = 0.f;
    }
    xcd_barrier(xbar); STAMP();
    {
        pg8::Gemm g{PROJ + 2048, WOUT0T, T, D, DI, N0}; pg8::StaticOrder S; S.init(T, D, G, bx);
        pg8::EpiOut E{a.x, nullptr, H1BF, SUMSQ1};
        pg8::gemm_phase<pg8::EpiOut>(lds, g, S, E);
    }
    xcd_barrier(xbar); STAMP();
    {
        pg8::Gemm g{H1BF, W1T, T, N1, D, D}; pg8::StaticOrder S; S.init(T, N1, G, bx);
        pg8::EpiProj E{PROJ, N1, 1, SUMSQ1, nullptr, ROT};
        pg8::gemm_phase<pg8::EpiProj>(lds, g, S, E);
    }
    xcd_barrier(xbar); STAMP();
    prescan_phase<1>(lds, PROJ, ws + WS_ROT, pcu, G);
    xcd_barrier(xbar); STAMP();
    scan_phase<1>(lds, PROJ, ws + WS_ROT, pcu, G);
    xcd_barrier(xbar); STAMP();
    ew_phase<1>(PROJ, a.ret_gn_g, a.ret_gn_b, gw, NGW, lane);
    xcd_barrier(xbar); STAMP();
    {
        pg8::Gemm g{PROJ + 4096, WOUT1T, T, D, DI, N1}; pg8::StaticOrder S; S.init(T, D, G, bx);
        pg8::EpiOut E{nullptr, H1BF, H1BF, nullptr};
        pg8::gemm_phase<pg8::EpiOut>(lds, g, S, E);
    }
    xcd_barrier(xbar); STAMP();
    for (int m = gw; m < T; m += NGW) {
        const u32x4* hr = (const u32x4*)(H1BF + (size_t)m * D) + lane;
        u32x4 hv[4]; float s = 0.f;
#pragma unroll
        for (int j = 0; j < 4; ++j) { hv[j] = __builtin_nontemporal_load(hr + 64 * j);
#pragma unroll
            for (int q = 0; q < 4; ++q) { const float lo = bflo(hv[j][q]), hi = bfhi(hv[j][q]); s += lo * lo + hi * hi; } }
        const float rs = rsqrtf(wave_sum(s) * (1.0f / D) + EPS);
#pragma unroll
        for (int j = 0; j < 4; ++j) {
            const int col = 512 * j + 8 * lane;
            const f32x4 g0 = *(const f32x4*)(a.final_norm + col), g1 = *(const f32x4*)(a.final_norm + col + 4);
            f32x4 y0 = (f32x4){bflo(hv[j][0]), bfhi(hv[j][0]), bflo(hv[j][1]), bfhi(hv[j][1])} * rs * g0;
            f32x4 y1 = (f32x4){bflo(hv[j][2]), bfhi(hv[j][2]), bflo(hv[j][3]), bfhi(hv[j][3])} * rs * g1;
            __builtin_nontemporal_store(y0, (f32x4*)(a.out + (size_t)m * D + col)); __builtin_nontemporal_store(y1, (f32x4*)(a.out + (size_t)m * D + col + 4));
        }
    }
}

extern "C" void kernel_launch(void* const* d_in, const int* in_sizes, int n_in, void* d_out, int out_size, void* d_ws, size_t ws_size, hipStream_t stream) {
    static int grid = 0;
    if (grid == 0) {
        int dev = 0, cus = 0, per_cu = 0;
        (void)hipGetDevice(&dev);
        (void)hipDeviceGetAttribute(&cus, hipDeviceAttributeMultiprocessorCount, dev);
        (void)hipFuncSetAttribute((const void*)fwd, hipFuncAttributeMaxDynamicSharedMemorySize, LDS_BYTES);
        (void)hipOccupancyMaxActiveBlocksPerMultiprocessor(&per_cu, (const void*)fwd, 512, LDS_BYTES);
        if (per_cu < 1) per_cu = 1;
        grid = cus * per_cu;
        if (ws_size < 1024 * MiB) fprintf(stderr, "kernel_launch: workspace too small (%zu)\n", ws_size);
    }
    Args a{};
    a.x = (const float*)d_in[0]; a.pos = (const int*)d_in[1];
    a.gla_norm = (const float*)d_in[2]; a.gla_w_in = (const float*)d_in[3]; a.gla_w_a1 = (const float*)d_in[4]; a.gla_w_a2 = (const float*)d_in[5];
    a.gla_b_a = (const float*)d_in[6]; a.gla_head_g = (const float*)d_in[7]; a.gla_w_out = (const float*)d_in[8];
    a.ret_norm = (const float*)d_in[9]; a.ret_w_in = (const float*)d_in[10]; a.ret_gn_g = (const float*)d_in[11]; a.ret_gn_b = (const float*)d_in[12];
    a.ret_w_out = (const float*)d_in[13]; a.final_norm = (const float*)d_in[14];
    a.out = (float*)d_out; a.ws = (unsigned char*)d_ws;
    (void)hipMemsetAsync((char*)d_ws + WS_BAR, 0, WS_BAR_BYTES, stream);
    void* args[] = {&a};
    hipError_t e = hipLaunchCooperativeKernel((const void*)fwd, dim3(grid), dim3(512), args, LDS_BYTES, stream);
    if (e != hipSuccess) fprintf(stderr, "cooperative launch failed: %s (grid %d)\n", hipGetErrorString(e), grid);
}
```
